# Optimizing an MI355X kernel written in HIP

```python
import math
import jax
import jax.numpy as jnp
from jax import lax
import numpy as np

D_MODEL = 2048
BATCH = 8
SEQ = 2048
DEPTH = 1

BRANCH_WIDTH = D_MODEL // 2
N_BRANCHES = 2
HEAD_DIM = 128
ATTN_GROUPS = 3
WINDOWS = (128, 512, 2048)
DILATIONS = (1, 4, 16)
ATTN_HEADS = BRANCH_WIDTH // HEAD_DIM
QKV_WIDTH = ATTN_GROUPS * ATTN_HEADS * HEAD_DIM
ATTN_BLOCK = 128
NUM_BUCKETS = 32
MAX_DISTANCE = 2048
SGU_CHUNK = 128
SGU_GROUP_DIM = 128
SGU_GROUPS = BRANCH_WIDTH // SGU_GROUP_DIM
IN_COLS = 3 * QKV_WIDTH + 2 * BRANCH_WIDTH + N_BRANCHES * D_MODEL
N_EXPERTS = 32
TOP_K = 4
EXPERT_HIDDEN = D_MODEL
SWIGLU_ALPHA = 1.702
SWIGLU_LIMIT = 7.0
MOE_BLOCK = 512
LN_EPS = 1e-5

kernel_name = "hybrid_dilated_attn_gmlp_moe_deepnorm"


def layer_norm(x, g, b):
    xf = x.astype(jnp.float32)
    mu = jnp.mean(xf, axis=-1, keepdims=True)
    var = jnp.mean(jnp.square(xf - mu), axis=-1, keepdims=True)
    return ((xf - mu) * lax.rsqrt(var + LN_EPS) * g + b).astype(x.dtype)


def t5_bucket(dist):
    exact = NUM_BUCKETS // 2
    d = jnp.maximum(dist, 1).astype(jnp.float32)
    large = exact + (jnp.log(d / exact) / math.log(MAX_DISTANCE / exact)
                     * (NUM_BUCKETS - exact)).astype(jnp.int32)
    large = jnp.minimum(large, NUM_BUCKETS - 1)
    return jnp.where(dist < exact, dist, large)


def dilated_group_attention(q, k, v, bias_table, window, dilation):
    B, S, H, Dh = q.shape
    r = dilation
    span = window // dilation
    L = S // r
    nb = -(-L // ATTN_BLOCK)
    Lp = nb * ATTN_BLOCK

    def to_sub(t):
        t = t.reshape(B, L, r, H, Dh).transpose(0, 2, 1, 3, 4)
        t = jnp.pad(t, ((0, 0), (0, 0), (0, Lp - L), (0, 0), (0, 0)))
        return t.reshape(B, r, nb, ATTN_BLOCK, H, Dh)

    def with_prev(t):
        prev = jnp.pad(t[:, :, :-1], ((0, 0), (0, 0), (1, 0), (0, 0), (0, 0), (0, 0)))
        return jnp.concatenate([prev, t], axis=3)

    qb = to_sub(q)
    kw = with_prev(to_sub(k))
    vw = with_prev(to_sub(v))
    qi = jnp.arange(ATTN_BLOCK, dtype=jnp.int32)[:, None]
    kj = jnp.arange(2 * ATTN_BLOCK, dtype=jnp.int32)[None, :]
    sub_dist = qi + ATTN_BLOCK - kj
    band = (sub_dist >= 0) & (sub_dist <= span)
    bias = bias_table[t5_bucket(r * jnp.clip(sub_dist, 0, span))]
    bias = bias.transpose(2, 0, 1).astype(jnp.float32)
    has_prev = (jnp.arange(nb)[:, None, None] > 0) | (kj[None] >= ATTN_BLOCK)
    valid = band[None] & has_prev

    scores = jnp.einsum('brnqhd,brnkhd->brnhqk', qb, kw).astype(jnp.float32)
    scores = scores * (HEAD_DIM ** -0.5) + bias
    scores = jnp.where(valid[:, None], scores, -jnp.inf)
    m = jnp.max(scores, axis=-1, keepdims=True)
    p = jnp.exp(scores - m)
    denom = jnp.sum(p, axis=-1, keepdims=True)
    o = jnp.einsum('brnhqk,brnkhd->brnqhd', (p / denom).astype(v.dtype), vw)
    lse = (m + jnp.log(denom))[..., 0]
    o = o.reshape(B, r, Lp, H, Dh)[:, :, :L].transpose(0, 2, 1, 3, 4).reshape(B, S, H, Dh)
    lse = lse.transpose(0, 1, 2, 4, 3).reshape(B, r, Lp, H)[:, :, :L]
    lse = lse.transpose(0, 2, 1, 3).reshape(B, S, H)
    return o, lse


def dilated_attention(q, k, v, bias_table):
    outs, lses = [], []
    for g in range(ATTN_GROUPS):
        o, l = dilated_group_attention(q[:, :, g], k[:, :, g], v[:, :, g],
                                       bias_table[:, g], WINDOWS[g], DILATIONS[g])
        outs.append(o)
        lses.append(l)
    out = jnp.stack(outs, axis=0)
    lse = jnp.stack(lses, axis=0)
    w = jax.nn.softmax(lse, axis=0)
    return jnp.sum(w[..., None].astype(out.dtype) * out, axis=0)


def spatial_gating(z, ln_g, ln_b, w_s, b_s):
    B, S, _ = z.shape
    z = jax.nn.gelu(z)
    u, v = z[..., :BRANCH_WIDTH], z[..., BRANCH_WIDTH:]
    v = layer_norm(v, ln_g, ln_b)
    vc = v.reshape(B, S // SGU_CHUNK, SGU_CHUNK, SGU_GROUPS, SGU_GROUP_DIM)
    causal = jnp.tril(jnp.ones((SGU_CHUNK, SGU_CHUNK), dtype=bool))
    w = jnp.where(causal[None], w_s, 0.0).astype(v.dtype)
    mixed = jnp.einsum('gij,bcjgd->bcigd', w, vc) + b_s.T[None, None, :, :, None]
    return u * mixed.reshape(B, S, BRANCH_WIDTH)


def moe_ffn(h, w_router, b_router, w_gu, b_gu, w_down, b_down):
    B, S, D = h.shape
    T = B * S
    A = T * TOP_K
    ht = h.reshape(T, D)
    logits = (ht @ w_router + b_router).astype(jnp.float32)
    top_val, top_idx = lax.top_k(logits, TOP_K)
    gate = jax.nn.softmax(top_val, axis=-1)
    flat_e = top_idx.reshape(A).astype(jnp.int32)
    flat_tok = jnp.repeat(jnp.arange(T, dtype=jnp.int32), TOP_K)
    flat_gate = gate.reshape(A)
    order = jnp.argsort(flat_e)
    sorted_e = flat_e[order]
    counts = jnp.bincount(flat_e, length=N_EXPERTS).astype(jnp.int32)
    padded = (counts + MOE_BLOCK - 1) // MOE_BLOCK * MOE_BLOCK
    start = jnp.cumsum(counts) - counts
    pend = jnp.cumsum(padded)
    pstart = pend - padded
    rank = jnp.arange(A, dtype=jnp.int32) - start[sorted_e]
    dest = pstart[sorted_e] + rank
    n_blocks = (A + N_EXPERTS * MOE_BLOCK + MOE_BLOCK - 1) // MOE_BLOCK
    cap = n_blocks * MOE_BLOCK
    slot_tok = jnp.zeros((cap,), jnp.int32).at[dest].set(flat_tok[order])
    slot_gate = jnp.zeros((cap,), jnp.float32).at[dest].set(flat_gate[order])
    block_start = jnp.arange(n_blocks, dtype=jnp.int32) * MOE_BLOCK
    block_e = jnp.minimum(jnp.searchsorted(pend, block_start, side='right'), N_EXPERTS - 1)

    def expert_block(args):
        e, tok = args
        xb = ht[tok]
        hb = xb @ w_gu[e] + b_gu[e]
        glu = jnp.minimum(hb[:, :EXPERT_HIDDEN], SWIGLU_LIMIT)
        lin = jnp.clip(hb[:, EXPERT_HIDDEN:], -SWIGLU_LIMIT, SWIGLU_LIMIT)
        act = glu * jax.nn.sigmoid(SWIGLU_ALPHA * glu) * (lin + 1.0)
        return act @ w_down[e] + b_down[e]

    y = lax.map(expert_block, (block_e, slot_tok.reshape(n_blocks, MOE_BLOCK)))
    y = (y.reshape(cap, D) * slot_gate[:, None]).astype(h.dtype)
    out = jnp.zeros((T, D), h.dtype).at[slot_tok].add(y)
    return out.reshape(B, S, D)


def setup_inputs(seed: int = 0) -> dict:
    key = jax.random.key(seed)
    ks = jax.random.split(key, 24)
    f32 = jnp.float32
    L = DEPTH
    beta = (8.0 * DEPTH) ** -0.25

    def nrm(k, shape, scale):
        return jax.random.normal(k, shape, f32) * scale

    x = nrm(ks[0], (BATCH, SEQ, D_MODEL), 1.0)
    w_qk = nrm(ks[1], (L, D_MODEL, 2 * QKV_WIDTH), D_MODEL ** -0.5)
    w_v = nrm(ks[2], (L, D_MODEL, QKV_WIDTH), beta * D_MODEL ** -0.5)
    w_z = nrm(ks[3], (L, D_MODEL, 2 * BRANCH_WIDTH), D_MODEL ** -0.5)
    w_g = nrm(ks[4], (L, D_MODEL, N_BRANCHES * D_MODEL), D_MODEL ** -0.5)
    w_in = jnp.concatenate([w_qk, w_v, w_z, w_g], axis=-1)
    rel_bias = nrm(ks[5], (NUM_BUCKETS, ATTN_GROUPS * ATTN_HEADS), 0.5)
    sgu_ln_g = 1.0 + nrm(ks[6], (L, BRANCH_WIDTH), 0.05)
    sgu_ln_b = nrm(ks[7], (L, BRANCH_WIDTH), 0.02)
    sgu_w = nrm(ks[8], (L, SGU_GROUPS, SGU_CHUNK, SGU_CHUNK), SGU_CHUNK ** -0.5)
    sgu_b = 1.0 + nrm(ks[9], (L, SGU_GROUPS, SGU_CHUNK), 0.01)
    w_branch = nrm(ks[10], (L, N_BRANCHES, BRANCH_WIDTH, D_MODEL), beta * BRANCH_WIDTH ** -0.5)
    w_out = nrm(ks[11], (L, D_MODEL, D_MODEL), beta * D_MODEL ** -0.5)
    ln1_g = 1.0 + nrm(ks[12], (L, D_MODEL), 0.05)
    ln1_b = nrm(ks[13], (L, D_MODEL), 0.02)
    w_router = nrm(ks[14], (L, D_MODEL, N_EXPERTS), D_MODEL ** -0.5)
    b_router = nrm(ks[15], (L, N_EXPERTS), 0.01)
    w_gu = nrm(ks[16], (L, N_EXPERTS, D_MODEL, 2 * EXPERT_HIDDEN), beta * D_MODEL ** -0.5)
    b_gu = nrm(ks[17], (L, N_EXPERTS, 2 * EXPERT_HIDDEN), 0.01)
    w_down = nrm(ks[18], (L, N_EXPERTS, EXPERT_HIDDEN, D_MODEL), beta * EXPERT_HIDDEN ** -0.5)
    b_down = nrm(ks[19], (L, N_EXPERTS, D_MODEL), 0.01)
    ln2_g = 1.0 + nrm(ks[20], (L, D_MODEL), 0.05)
    ln2_b = nrm(ks[21], (L, D_MODEL), 0.02)
    return {"x": x, "w_in": w_in, "rel_bias": rel_bias, "sgu_ln_g": sgu_ln_g,
            "sgu_ln_b": sgu_ln_b, "sgu_w": sgu_w, "sgu_b": sgu_b, "w_branch": w_branch,
            "w_out": w_out, "ln1_g": ln1_g, "ln1_b": ln1_b, "w_router": w_router,
            "b_router": b_router, "w_gu": w_gu, "b_gu": b_gu, "w_down": w_down,
            "b_down": b_down, "ln2_g": ln2_g, "ln2_b": ln2_b}


def reference(x, w_in, rel_bias, sgu_ln_g, sgu_ln_b, sgu_w, sgu_b, w_branch, w_out,
              ln1_g, ln1_b, w_router, b_router, w_gu, b_gu, w_down, b_down, ln2_g, ln2_b):
    alpha = (2.0 * DEPTH) ** 0.25
    B, S, D = x.shape
    bias_table = rel_bias.reshape(NUM_BUCKETS, ATTN_GROUPS, ATTN_HEADS)
    o_k, o_v, o_z, o_g = QKV_WIDTH, 2 * QKV_WIDTH, 3 * QKV_WIDTH, 3 * QKV_WIDTH + 2 * BRANCH_WIDTH
    h = x
    for l in range(DEPTH):
        proj = h @ w_in[l]
        q = proj[..., :o_k].reshape(B, S, ATTN_GROUPS, ATTN_HEADS, HEAD_DIM)
        k = proj[..., o_k:o_v].reshape(B, S, ATTN_GROUPS, ATTN_HEADS, HEAD_DIM)
        v = proj[..., o_v:o_z].reshape(B, S, ATTN_GROUPS, ATTN_HEADS, HEAD_DIM)
        z = proj[..., o_z:o_g]
        gates = jax.nn.sigmoid(proj[..., o_g:].reshape(B, S, N_BRANCHES, D))
        y_attn = dilated_attention(q, k, v, bias_table).reshape(B, S, BRANCH_WIDTH)
        y_sgu = spatial_gating(z, sgu_ln_g[l], sgu_ln_b[l], sgu_w[l], sgu_b[l])
        branches = jnp.stack([y_attn, y_sgu], axis=2)
        y = jnp.einsum('bsnc,ncd->bsnd', branches, w_branch[l])
        mixed = jnp.sum(gates * y, axis=2) @ w_out[l]
        h = layer_norm(alpha * h + mixed, ln1_g[l], ln1_b[l])
        ffn = moe_ffn(h, w_router[l], b_router[l], w_gu[l], b_gu[l], w_down[l], b_down[l])
        h = layer_norm(alpha * h + ffn, ln2_g[l], ln2_b[l])
    return h
```

```cpp
#include <hip/hip_runtime.h>
#include <cstdio>
#include <cstdint>

#ifndef MK_N_LAUNCHES
#define MK_N_LAUNCHES 1
#endif

#ifndef CONV1_WGS
#define CONV1_WGS 1
#endif
#ifndef CONV2_WGS
#define CONV2_WGS 1
#endif
#ifndef P1_FP8
#define P1_FP8 1
#endif
#ifndef P1_Z_BF16
#define P1_Z_BF16 1
#endif
#ifndef P1_I8
#define P1_I8 1
#endif
#ifndef P5_FP8
#define P5_FP8 1
#endif
#ifndef T0_FP8
#define T0_FP8 1
#endif
#ifndef P4B_FP8
#define P4B_FP8 1
#endif
#ifndef PROBE_DBL
#define PROBE_DBL -1
#endif
#define DBL(k) ((PROBE_DBL == (k)) ? 2 : 1)
#ifndef PROBE_PHASE
#define PROBE_PHASE -1
#endif
#ifndef PROBE_N
#define PROBE_N 1
#endif
#define REPS(k)
#define LAS __attribute__((address_space(3)))
#define GAS __attribute__((address_space(1)))
typedef unsigned short bf16_t;
typedef short bf16x8 __attribute__((ext_vector_type(8)));
typedef short s16x4 __attribute__((ext_vector_type(4)));
typedef float f32x4 __attribute__((ext_vector_type(4)));
typedef float f32x2 __attribute__((ext_vector_type(2)));
typedef unsigned u32x4 __attribute__((ext_vector_type(4)));
typedef unsigned u32x2 __attribute__((ext_vector_type(2)));

constexpr int NB = 8, SEQ = 2048, DM = 2048, T = NB * SEQ;
constexpr int QKVW = 3072, INC = 15360;
constexpr int O_K = 3072, O_V = 6144, O_Z = 9216, O_G = 11264;
constexpr int BW = 1024;
constexpr int NE = 32, TOPK = 4, EH = 2048;
constexpr float LN_EPS = 1e-5f;
constexpr float ALPHA = 1.189207115002721f;
constexpr int SLOT_CAP = 73728;
constexpr int NWAVES = 8, NTHR = 512;

constexpr size_t MiB = 1u << 20;
constexpr size_t WS_CTL = 0, CTL_ZERO_BYTES = 1 * MiB;
constexpr size_t WS_TOKE = 1 * MiB;
constexpr size_t WS_TOKR = WS_TOKE + 256 * 1024;
constexpr size_t WS_CGB = 1 * MiB + 512 * 1024;
constexpr size_t WS_XS = WS_CGB + 4096;
constexpr size_t WS_WCS = WS_XS + 65536;
constexpr size_t WS_SLOTTOK = 2 * MiB;
constexpr size_t WS_SLOTGATE = 4 * MiB;
constexpr size_t WS_LSE = 6 * MiB;
constexpr size_t WS_WBR = 8 * MiB;
constexpr size_t WS_WOUT = 16 * MiB;
constexpr size_t WS_WIN = 24 * MiB;
constexpr size_t WS_XB = 84 * MiB;
constexpr size_t WS_WGU = 148 * MiB;
constexpr size_t WS_WDN = 660 * MiB;
constexpr size_t WS_P = 916 * MiB;
constexpr size_t WS_OG = 1396 * MiB;
constexpr size_t WS_YA = 1492 * MiB;
constexpr size_t WS_YS = 1524 * MiB;
constexpr size_t WS_T0 = 1556 * MiB;
constexpr size_t WS_MP = 1620 * MiB;
constexpr size_t WS_R1 = 1684 * MiB;
constexpr size_t WS_H = 1812 * MiB;
constexpr size_t WS_HB = 1940 * MiB;
constexpr size_t WS_WG3 = 1940 * MiB + 1 * MiB;
constexpr size_t WS_ACT = 2004 * MiB;
constexpr size_t WS_Y = 2292 * MiB;
constexpr size_t WS_QKV = 2580 * MiB;
constexpr size_t WS_END = 2868 * MiB;
constexpr int CW_BAR = 4096;
constexpr int CW_CNT = 16384;

constexpr int RING_BYTES = 131072;
constexpr int TOKTAB_OFF = RING_BYTES;
constexpr int TOKTAB_UNITS = 20;
constexpr int SMALL_OFF = TOKTAB_OFF + TOKTAB_UNITS * 1024;
constexpr int MISC_OFF = SMALL_OFF + 1024;
constexpr int EPI_OFF = MISC_OFF + 256;
constexpr int LDS_BYTES = EPI_OFF + 4096;

#define RLX_AGENT __ATOMIC_RELAXED, __HIP_MEMORY_SCOPE_AGENT
#define LDS_WAIT() asm volatile("s_waitcnt lgkmcnt(0)" ::: "memory")
#define VM_WAIT() asm volatile("s_waitcnt vmcnt(0)" ::: "memory")
__device__ __forceinline__ unsigned cvt_pk_bf16(float lo, float hi) { unsigned r; asm volatile("v_cvt_pk_bf16_f32 %0, %1, %2" : "=v"(r) : "v"(lo), "v"(hi)); return r; }
__device__ __forceinline__ float bf_lo(unsigned w) { return __uint_as_float(w << 16); }
__device__ __forceinline__ float bf_hi(unsigned w) { return __uint_as_float(w & 0xffff0000u); }
template <int CTRL> __device__ __forceinline__ float dppf(float v) { return __builtin_bit_cast(float, __builtin_amdgcn_update_dpp(0, __builtin_bit_cast(int, v), CTRL, 0xf, 0xf, true)); }
__device__ __forceinline__ float wave_sum(float v) {
    v += dppf<0xB1>(v); v += dppf<0x4E>(v); v += dppf<0x141>(v); v += dppf<0x140>(v);
    { const unsigned b = __builtin_bit_cast(unsigned, v); auto r = __builtin_amdgcn_permlane16_swap(b, b, false, false); v = __builtin_bit_cast(float, (unsigned)r[0]) + __builtin_bit_cast(float, (unsigned)r[1]); }
    { const unsigned b = __builtin_bit_cast(unsigned, v); auto r = __builtin_amdgcn_permlane32_swap(b, b, false, false); v = __builtin_bit_cast(float, (unsigned)r[0]) + __builtin_bit_cast(float, (unsigned)r[1]); }
    return v;
}
__device__ __forceinline__ float wave_max(float v) {
    v = fmaxf(v, dppf<0xB1>(v)); v = fmaxf(v, dppf<0x4E>(v)); v = fmaxf(v, dppf<0x141>(v)); v = fmaxf(v, dppf<0x140>(v));
    { const unsigned b = __builtin_bit_cast(unsigned, v); auto r = __builtin_amdgcn_permlane16_swap(b, b, false, false); v = fmaxf(__builtin_bit_cast(float, (unsigned)r[0]), __builtin_bit_cast(float, (unsigned)r[1])); }
    { const unsigned b = __builtin_bit_cast(unsigned, v); auto r = __builtin_amdgcn_permlane32_swap(b, b, false, false); v = fmaxf(__builtin_bit_cast(float, (unsigned)r[0]), __builtin_bit_cast(float, (unsigned)r[1])); }
    return v;
}
__device__ __forceinline__ float rows_sum(float v) {
    { const unsigned b = __builtin_bit_cast(unsigned, v); auto r = __builtin_amdgcn_permlane16_swap(b, b, false, false); v = __builtin_bit_cast(float, (unsigned)r[0]) + __builtin_bit_cast(float, (unsigned)r[1]); }
    { const unsigned b = __builtin_bit_cast(unsigned, v); auto r = __builtin_amdgcn_permlane32_swap(b, b, false, false); v = __builtin_bit_cast(float, (unsigned)r[0]) + __builtin_bit_cast(float, (unsigned)r[1]); }
    return v; }
__device__ __forceinline__ float rows_max(float v) {
    { const unsigned b = __builtin_bit_cast(unsigned, v); auto r = __builtin_amdgcn_permlane16_swap(b, b, false, false); v = fmaxf(__builtin_bit_cast(float, (unsigned)r[0]), __builtin_bit_cast(float, (unsigned)r[1])); }
    { const unsigned b = __builtin_bit_cast(unsigned, v); auto r = __builtin_amdgcn_permlane32_swap(b, b, false, false); v = fmaxf(__builtin_bit_cast(float, (unsigned)r[0]), __builtin_bit_cast(float, (unsigned)r[1])); }
    return v; }
__device__ __forceinline__ float fast_sigmoid(float x) { return __builtin_amdgcn_rcpf(1.0f + __builtin_amdgcn_exp2f(-1.4426950408889634f * x)); }
__device__ __forceinline__ float gelu_tanh(float x) { const float y = 1.5957691216057308f * (x + 0.044715f * x * x * x); return x * fast_sigmoid(y); }
__device__ __forceinline__ unsigned off_b(unsigned row, unsigned ch) { return 256u * row + 16u * (ch ^ (((row & 3) << 2) | ((row >> 2) & 3))); }

#define XB_TMO      128
#define XB_XCNT(j)  (256  + 64 * (j))
#define XB_XSUB(j)  (1280 + 64 * (j))
#define XB_XGEN(j)  (2304 + 64 * (j))
#define XB_TOP      3328
#define XB_TOPGEN   3392
#define XCD_BAR_WORDS 3456
#define XB_SPIN_CAP (1u << 18)
__device__ __forceinline__ unsigned xb_ld(unsigned* p)              { return __hip_atomic_load(p, __ATOMIC_RELAXED, __HIP_MEMORY_SCOPE_AGENT); }
__device__ __forceinline__ unsigned xb_add(unsigned* p, unsigned v) { return __hip_atomic_fetch_add(p, v, __ATOMIC_RELAXED, __HIP_MEMORY_SCOPE_AGENT); }
__device__ __forceinline__ unsigned xb_xcc_id() { return (unsigned)__builtin_amdgcn_s_getreg((3 << 11) | 20) & 0xFu; }
#define XB_SPIN(cond, bar) do { unsigned _sp = 0; while (cond) { __builtin_amdgcn_s_sleep(1); \
    if ((++_sp & 255u) == 0u) { if (xb_ld(&(bar)[XB_TMO])) break; if (_sp > XB_SPIN_CAP) { atomicAdd(&(bar)[XB_TMO], 1u); break; } } } } while (0)
struct XcdBarrier { unsigned* bar; unsigned x; volatile LAS unsigned* st; };
__device__ __forceinline__ XcdBarrier xcd_barrier_post(unsigned* bar, volatile LAS unsigned* st) {
    XcdBarrier b; b.bar = bar; b.x = xb_xcc_id(); b.st = st;
    if (threadIdx.x == 0) (void)xb_add(&bar[XB_XCNT(b.x)], 1u);
    return b;
}
__device__ __forceinline__ void xcd_barrier_complete(unsigned* bar, unsigned x, unsigned& nloc, unsigned& nx) {
    const unsigned G = gridDim.x * gridDim.y * gridDim.z;
    unsigned sum, cnt, mine, sp = 0u;
    for (;;) {
        sum = 0u; cnt = 0u; mine = 0u;
#pragma unroll
        for (unsigned j = 0; j < 16; ++j) { const unsigned c = xb_ld(&bar[XB_XCNT(j)]); sum += c; cnt += (c > 0u) ? 1u : 0u; mine = (j == x) ? c : mine; }
        if (sum == G) break;
        __builtin_amdgcn_s_sleep(1);
        if ((++sp & 255u) == 0u) { if (xb_ld(&bar[XB_TMO])) break; if (sp > XB_SPIN_CAP) { atomicAdd(&bar[XB_TMO], 1u); break; } }
    }
    nloc = mine > 0u ? mine : 1u; nx = cnt > 0u ? cnt : 1u;
}
__device__ __forceinline__ void xcd_barrier(const XcdBarrier& b) {
    asm volatile("s_waitcnt vmcnt(0)" ::: "memory");
    __syncthreads();
    if (threadIdx.x == 0) {
        unsigned* bar = b.bar;
        __builtin_amdgcn_s_waitcnt(0);
        unsigned nloc = b.st[0], nx = b.st[1];
        if (nloc == 0u) { xcd_barrier_complete(bar, b.x, nloc, nx); b.st[0] = nloc; b.st[1] = nx; }
        const unsigned old = xb_add(&bar[XB_XSUB(b.x)], 1u);
        const unsigned gen = old / nloc;
        if (old + 1u == (gen + 1u) * nloc) {
            __builtin_amdgcn_fence(__ATOMIC_RELEASE, "agent");
            asm volatile("s_waitcnt vmcnt(0)" ::: "memory");
            const unsigned og = xb_add(&bar[XB_TOP], 1u);
            const unsigned tg = og / nx;
            if (og + 1u == (tg + 1u) * nx) xb_add(&bar[XB_TOPGEN], 1u);
            else XB_SPIN(xb_ld(&bar[XB_TOPGEN]) == tg, bar);
            __builtin_amdgcn_fence(__ATOMIC_ACQUIRE, "agent");
            xb_add(&bar[XB_XGEN(b.x)], 1u);
            asm volatile("s_waitcnt vmcnt(0)" ::: "memory");
        } else {
            XB_SPIN(xb_ld(&bar[XB_XGEN(b.x)]) == gen, bar);
            __builtin_amdgcn_fence(__ATOMIC_ACQUIRE, "agent");
            asm volatile("s_waitcnt vmcnt(0)" ::: "memory");
        }
    }
    __syncthreads();
}

namespace pg8 {
constexpr int BM = 256, BK = 64, HALF = 128, HTB = HALF * BK * 2, STAGE_BYTES = 8 * HTB, NXCD = 8, WGM = 8;
__device__ __forceinline__ int lds_byte(int r, int c) { const int st = (r >> 4) * 2 + (c >> 5), rr = r & 15, cc = c & 31, ob = rr * 64 + cc * 2; return st * 1024 + (ob ^ (((ob >> 9) & 1) << 5)); }
__device__ __forceinline__ void stage_rc(int b, int& R, int& C) { const int st = b / 1024, sb = b % 1024, swz = sb ^ (((sb >> 9) & 1) << 5); R = (st >> 1) * 16 + swz / 64; C = (st & 1) * 32 + (swz % 64) / 2; }
__device__ __forceinline__ int perm32(int rho) { const int n = rho >> 4, i = rho & 15; return 8 * (i >> 2) + 4 * n + (i & 3); }

struct Unit { int pm, pn, e, ord; };

__device__ __forceinline__ int xcd_remap(int L, int nwg) { const int q = nwg / NXCD, r = nwg % NXCD, xcd = L % NXCD, off = L / NXCD; return (xcd < r ? xcd * (q + 1) : r * (q + 1) + (xcd - r) * q) + off; }

template <int DT> struct DenseT {
    static constexpr bool GATHER = false, FP8 = (DT == 1), I8 = (DT == 2);
    const bf16_t* A; const bf16_t* Bt; int K; int nM, nN, nwg, G, c, i0, i1, pn_off, gap_lo, gap_n, rep, ranged;
    __device__ void init(const bf16_t* A_, const bf16_t* Bt_, int M, int N, int K_, int G_, int c_) { A = A_; Bt = Bt_; K = K_; nM = M / BM; nN = N / BM; nwg = nM * nN; G = G_; c = c_; i0 = 0; i1 = 1 << 28; pn_off = 0; gap_lo = 1 << 28; gap_n = 0; rep = 1; ranged = 0; }
    __device__ __forceinline__ bool next(int i_, Unit& u) const {
        const int i = i_ + i0; const long L = (long)i * G + c; if (i >= i1 || L >= (long)nwg * rep) return false;
        if (ranged) {
            int l = (int)(L % nwg); const int U0 = nM * 16, U1 = nM * 36; int pn0 = 44, nNr = 16;
            if (l >= U0 + U1) { l -= U0 + U1; pn0 = 36; nNr = 8; } else if (l >= U0) { l -= U0; pn0 = 0; nNr = 36; }
            const int wgid = xcd_remap(l, nM * nNr), nig = WGM * nNr, gid = wgid / nig, fm = gid * WGM, gsz = (nM - fm) < WGM ? (nM - fm) : WGM;
            u.pm = fm + ((wgid % nig) % gsz); u.pn = pn0 + (wgid % nig) / gsz; u.e = 0; u.ord = i; return true; }
        const int wgid = xcd_remap((int)(L % nwg), nwg);
        const int nig = WGM * nN, gid = wgid / nig, fm = gid * WGM, gsz = (nM - fm) < WGM ? (nM - fm) : WGM;
        u.pm = fm + ((wgid % nig) % gsz); u.pn = (wgid % nig) / gsz + pn_off; if (u.pn >= gap_lo) u.pn += gap_n; u.e = 0; u.ord = i; return true;
    }
    __device__ __forceinline__ bool half_only(const Unit&) const { return false; }
    __device__ __forceinline__ const char* a_base(const Unit& u) const { return (const char*)A + (size_t)u.pm * BM * K * 2; }
    __device__ __forceinline__ const char* b_base(const Unit& u) const { return (const char*)Bt + (size_t)(u.pn - pn_off) * BM * K * 2; }
    __device__ __forceinline__ void a_offs(const Unit&, const int (&R)[2], const int (&C)[2], unsigned (&vo)[2][2]) const {
#pragma unroll
        for (int h = 0; h < 2; ++h)
#pragma unroll
            for (int i = 0; i < 2; ++i) vo[h][i] = (unsigned)((R[i] + h * HALF) * K + C[i]) * 2u;
    }
};
typedef DenseT<0> Dense; typedef DenseT<1> Dense8; typedef DenseT<2> DenseI8;
constexpr int MOE_MAX_UNITS = 20;
template <bool GATHER_, bool FP8_> struct Moe {
    static constexpr bool GATHER = GATHER_, FP8 = FP8_, I8 = false;
    const bf16_t* A; const bf16_t* Bt; int K; int nN, G, c, i0, i1, rep; const LAS int* tpre; const LAS int* toktab; const LAS int* cnt; const LAS int* utab;
    __device__ __forceinline__ bool scan(int i, Unit& u) const {
        const int nwg = tpre[NE] * nN; const long L = (long)i * G + c; if (L >= (long)nwg * rep) return false;
        const int w = xcd_remap((int)(L % nwg), nwg);
        int e = 0;
        while (e < NE - 1 && tpre[e + 1] * nN <= w) ++e;
        const int te = tpre[e + 1] - tpre[e], local = w - tpre[e] * nN;
        u.e = e; u.pn = local / te; u.pm = local % te; u.ord = i; return true;
    }
    __device__ __forceinline__ void fill_units(int tid) const {
        LAS int* ut = (LAS int*)utab;
        if (tid < MOE_MAX_UNITS) { Unit u; const bool ok = scan(tid, u); ut[tid * 4] = ok ? u.e : -1; ut[tid * 4 + 1] = u.pm; ut[tid * 4 + 2] = u.pn; }
        __syncthreads();
    }
    __device__ __forceinline__ bool next(int i_, Unit& u) const {
        const int i = i_ + i0; if (i >= i1 || i >= MOE_MAX_UNITS) return false;
        const int e = __builtin_amdgcn_readfirstlane(utab[i * 4]); if (e < 0) return false;
        u.e = e; u.pm = __builtin_amdgcn_readfirstlane(utab[i * 4 + 1]); u.pn = __builtin_amdgcn_readfirstlane(utab[i * 4 + 2]); u.ord = i; return true;
    }
    __device__ __forceinline__ bool half_only(const Unit& u) const { return cnt[u.e] - u.pm * BM <= HALF; }
    __device__ __forceinline__ const char* a_base(const Unit& u) const { return GATHER ? (const char*)A : (const char*)A + (size_t)(tpre[u.e] + u.pm) * BM * K * 2; }
    __device__ __forceinline__ const char* b_base(const Unit& u) const { return (const char*)Bt + ((size_t)u.e * nN + u.pn) * BM * K * 2; }
    __device__ __forceinline__ void a_offs(const Unit& u, const int (&R)[2], const int (&C)[2], unsigned (&vo)[2][2]) const {
#pragma unroll
        for (int h = 0; h < 2; ++h)
#pragma unroll
            for (int i = 0; i < 2; ++i) {
                if (GATHER) { const int tok = toktab[u.ord * 256 + R[i] + h * HALF]; vo[h][i] = (unsigned)(tok * K + C[i]) * 2u; }
                else vo[h][i] = (unsigned)((R[i] + h * HALF) * K + C[i]) * 2u;
            }
    }
};

typedef int i32x8 __attribute__((ext_vector_type(8)));
typedef int i32x4 __attribute__((ext_vector_type(4)));
__device__ __forceinline__ i32x8 cat8(bf16x8 lo, bf16x8 hi) { return __builtin_shufflevector(__builtin_bit_cast(i32x4, lo), __builtin_bit_cast(i32x4, hi), 0, 1, 2, 3, 4, 5, 6, 7); }
constexpr float W8_MUL = 64.0f, W8_INV = 1.0f / 64.0f;
constexpr float Y_MUL = 16.0f;
constexpr float T0_MUL = 16.0f;
constexpr float YS_MUL = 16.0f;
constexpr float MP_MUL = 16.0f;
constexpr float YA_MUL = 16.0f;
template <class Epi, class Prob>
__device__ __forceinline__ void gemm_phase(LAS unsigned char* lds, const Prob& S, const Epi& E) {
    int tid_ = threadIdx.x; asm volatile("" : "+v"(tid_));
    const int tid = tid_, wid = __builtin_amdgcn_readfirstlane(tid >> 6), lane = tid & 63, wr = wid >> 2, wc = wid & 3, fr = lane & 15, fq = lane >> 4;
    const int K = S.K, nt = K / BK;
    int Rp[2], Cp[2]; unsigned voffB[2];
#pragma unroll
    for (int i = 0; i < 2; ++i) { int R, C; stage_rc(tid * 16 + i * 8192, R, C); Rp[i] = R; Cp[i] = C; const int Rb = Epi::PERM ? ((R & ~31) + perm32(R & 31)) : R; voffB[i] = (unsigned)(Rb * K + C) * 2u; }
    const size_t kstep = (size_t)(BK * 2);
    const size_t hstep = (size_t)HALF * K * 2;
    const unsigned ldsw = (unsigned)wid * 1024u;
    const int aoff = lds_byte(wr * 64 + fr, fq * 8), boff = lds_byte(wc * 32 + fr, fq * 8);
#define PG8_SA(b, h) (((b) * 2 + (h)) * HTB)
#define PG8_SB(b, h) ((4 + (b) * 2 + (h)) * HTB)
#define PG8_STAGE(bufoff, gbase, voff) do { _Pragma("unroll") for (int _i = 0; _i < 2; ++_i) \
        __builtin_amdgcn_global_load_lds((const unsigned*)((const char*)(gbase) + (voff)[_i]), (LAS unsigned*)(lds + (bufoff) + ldsw + _i * 8192), 16, 0, 0); } while (0)
#define PG8_LDA(dst, b, h) do { if constexpr (Prob::FP8) { _Pragma("unroll") for (int m = 0; m < 4; ++m) dst##8[m] = cat8(*(const LAS bf16x8*)(lds + PG8_SA(b, h) + aoff + m * 2048), *(const LAS bf16x8*)(lds + PG8_SA(b, h) + aoff + m * 2048 + 1024)); } \
        else { _Pragma("unroll") for (int m = 0; m < 4; ++m) _Pragma("unroll") for (int k = 0; k < 2; ++k) dst[m][k] = *(const LAS bf16x8*)(lds + PG8_SA(b, h) + aoff + m * 2048 + k * 1024); } } while (0)
#define PG8_LDB(dst, b, h) do { if constexpr (Prob::FP8) { _Pragma("unroll") for (int n = 0; n < 2; ++n) dst##8[n] = cat8(*(const LAS bf16x8*)(lds + PG8_SB(b, h) + boff + n * 2048), *(const LAS bf16x8*)(lds + PG8_SB(b, h) + boff + n * 2048 + 1024)); } \
        else { _Pragma("unroll") for (int n = 0; n < 2; ++n) _Pragma("unroll") for (int k = 0; k < 2; ++k) dst[n][k] = *(const LAS bf16x8*)(lds + PG8_SB(b, h) + boff + n * 2048 + k * 1024); } } while (0)
#define PG8_MMA(ai, bj, At, Bt) do { __builtin_amdgcn_s_setprio(1); \
        if constexpr (Prob::FP8) { _Pragma("unroll") for (int m = 0; m < 4; ++m) _Pragma("unroll") for (int n = 0; n < 2; ++n) \
            asm("v_mfma_f32_16x16x128_f8f6f4 %0, %1, %2, %0" : "+v"(acc[ai][bj][m][n]) : "v"(Bt##8[n]), "v"(At##8[m])); } \
        else if constexpr (Prob::I8) { _Pragma("unroll") for (int m = 0; m < 4; ++m) _Pragma("unroll") for (int n = 0; n < 2; ++n) _Pragma("unroll") for (int k = 0; k < 2; ++k) \
            acc[ai][bj][m][n] = __builtin_bit_cast(f32x4, __builtin_amdgcn_mfma_i32_16x16x64_i8(__builtin_bit_cast(i32x4, Bt[n][k]), __builtin_bit_cast(i32x4, At[m][k]), __builtin_bit_cast(i32x4, acc[ai][bj][m][n]), 0, 0, 0)); } \
        else { _Pragma("unroll") for (int m = 0; m < 4; ++m) _Pragma("unroll") for (int n = 0; n < 2; ++n) _Pragma("unroll") for (int k = 0; k < 2; ++k) \
            acc[ai][bj][m][n] = __builtin_amdgcn_mfma_f32_16x16x32_bf16(Bt[n][k], At[m][k], acc[ai][bj][m][n], 0, 0, 0); } \
        __builtin_amdgcn_s_setprio(0); } while (0)
#define PG8_WAIT_V(n) asm volatile("s_waitcnt vmcnt(" #n ")" ::: "memory")
#define PG8_WAIT_L(n) asm volatile("s_waitcnt lgkmcnt(" #n ")" ::: "memory")
#define PG8_BAR __builtin_amdgcn_s_barrier()
#define PG8_SCHED __builtin_amdgcn_sched_barrier(0)
    Unit cur, nxt; int ui = 0;
    if (!S.next(0, cur)) return;
    LAS float* epi_tab = (LAS float*)(lds + EPI_OFF);
    if constexpr (Epi::HAS_PRE) __builtin_amdgcn_global_load_lds((const unsigned*)E.pre_src(cur, tid), (LAS unsigned*)(epi_tab + wid * 64), 4, 0, 0);
    f32x4 acc[2][2][4][2];
#pragma unroll
    for (int a = 0; a < 2; ++a)
#pragma unroll
        for (int b = 0; b < 2; ++b)
#pragma unroll
            for (int m = 0; m < 4; ++m)
#pragma unroll
                for (int n = 0; n < 2; ++n) acc[a][b][m][n] = (f32x4){0.f, 0.f, 0.f, 0.f};
    bf16x8 At[4][2], B0[2][2], B1[2][2]; i32x8 At8[4], B08[2], B18[2];
    unsigned voA[2][2], nvoA[2][2];
    S.a_offs(cur, Rp, Cp, voA);
    if constexpr (Prob::GATHER) { LDS_WAIT(); }
    const char* cA = S.a_base(cur); const char* cB = S.b_base(cur);
    PG8_STAGE(PG8_SB(0, 0), cB, voffB); PG8_STAGE(PG8_SB(0, 1), cB + hstep, voffB); PG8_STAGE(PG8_SA(0, 0), cA, voA[0]); PG8_STAGE(PG8_SA(0, 1), cA, voA[1]);
    if (wr == 1) PG8_BAR;
    PG8_WAIT_V(2); PG8_BAR;
    PG8_STAGE(PG8_SB(1, 0), cB + kstep, voffB); PG8_STAGE(PG8_SA(1, 0), cA + kstep, voA[0]); PG8_STAGE(PG8_SB(1, 1), cB + hstep + kstep, voffB);
    PG8_WAIT_V(6); PG8_BAR;
    for (;;) {
        const bool has_next = S.next(ui + 1, nxt);
        const bool half = __builtin_amdgcn_readfirstlane((int)S.half_only(cur)) != 0;
        const char* nA = has_next ? S.a_base(nxt) : cA; const char* nB = has_next ? S.b_base(nxt) : cB;
        if constexpr (Prob::GATHER) {
            if (has_next) S.a_offs(nxt, Rp, Cp, nvoA);
            else {
#pragma unroll
                for (int h = 0; h < 2; ++h)
#pragma unroll
                    for (int i = 0; i < 2; ++i) nvoA[h][i] = voA[h][i];
            }
        }
        for (int t = 0; t < nt; t += 2) {
            const bool last = (t == nt - 2);
            const char* a1 = cA + (size_t)(t + 1) * kstep;
            const char* a2 = last ? nA : cA + (size_t)(t + 2) * kstep; const char* b2 = last ? nB : cB + (size_t)(t + 2) * kstep;
            const char* a3 = a2 + kstep; const char* b3 = b2 + kstep;
            unsigned vo2[2][2];
#pragma unroll
            for (int h = 0; h < 2; ++h)
#pragma unroll
                for (int i = 0; i < 2; ++i) { if constexpr (Prob::GATHER) vo2[h][i] = last ? nvoA[h][i] : voA[h][i]; else vo2[h][i] = voA[h][i]; }
            PG8_LDB(B0, 0, 0); PG8_LDB(B1, 0, 1); PG8_SCHED; PG8_LDA(At, 0, 0); PG8_STAGE(PG8_SA(1, 1), a1, voA[1]);
            PG8_WAIT_V(8); PG8_WAIT_L(0); PG8_BAR; PG8_MMA(0, 0, At, B0); PG8_MMA(0, 1, At, B1); PG8_BAR; PG8_SCHED;
            PG8_LDA(At, 0, 1); PG8_STAGE(PG8_SB(0, 0), b2, voffB); PG8_STAGE(PG8_SB(0, 1), b2 + hstep, voffB); PG8_STAGE(PG8_SA(0, 0), a2, vo2[0]);
            PG8_WAIT_V(8); PG8_WAIT_L(0); PG8_BAR; if (!half) { PG8_MMA(1, 0, At, B0); PG8_MMA(1, 1, At, B1); } PG8_BAR; PG8_SCHED;
            PG8_LDB(B0, 1, 0); PG8_LDB(B1, 1, 1); PG8_SCHED; PG8_LDA(At, 1, 0); PG8_STAGE(PG8_SA(0, 1), a2, vo2[1]);
            PG8_WAIT_V(8); PG8_WAIT_L(0); PG8_BAR; PG8_MMA(0, 0, At, B0); PG8_MMA(0, 1, At, B1); PG8_BAR; PG8_SCHED;
            PG8_LDA(At, 1, 1); PG8_STAGE(PG8_SB(1, 0), b3, voffB); PG8_STAGE(PG8_SB(1, 1), b3 + hstep, voffB); PG8_STAGE(PG8_SA(1, 0), a3, vo2[0]);
            PG8_WAIT_V(8); PG8_WAIT_L(0); PG8_BAR; if (!half) { PG8_MMA(1, 0, At, B0); PG8_MMA(1, 1, At, B1); } PG8_BAR; PG8_SCHED;
        }
        if constexpr (Epi::HAS_PRE) { if (has_next) __builtin_amdgcn_global_load_lds((const unsigned*)E.pre_src(nxt, tid), (LAS unsigned*)(epi_tab + ((ui + 1) & 1) * 512 + wid * 64), 4, 0, 0); }
        if (wr == 0) PG8_BAR;
        if constexpr (Prob::FP8) asm volatile("s_nop 15\n\ts_nop 15" ::: "memory");
        if constexpr (Epi::HAS_PRE) E.run(acc, cur, wr, wc, fr, fq, epi_tab + (ui & 1) * 512);
        else E(acc, cur, wr, wc, fr, fq);
        if (!has_next) break;
#pragma unroll
        for (int a = 0; a < 2; ++a)
#pragma unroll
            for (int b = 0; b < 2; ++b)
#pragma unroll
                for (int m = 0; m < 4; ++m)
#pragma unroll
                    for (int n = 0; n < 2; ++n) acc[a][b][m][n] = (f32x4){0.f, 0.f, 0.f, 0.f};
        cur = nxt; cA = nA; cB = nB; ++ui;
        if constexpr (Prob::GATHER) {
#pragma unroll
            for (int h = 0; h < 2; ++h)
#pragma unroll
                for (int i = 0; i < 2; ++i) voA[h][i] = nvoA[h][i];
        }
        if (wr == 1) PG8_BAR;
    }
    PG8_WAIT_V(0);
    PG8_BAR;
#undef PG8_SA
#undef PG8_SB
#undef PG8_STAGE
#undef PG8_LDA
#undef PG8_LDB
#undef PG8_MMA
#undef PG8_WAIT_V
#undef PG8_WAIT_L
#undef PG8_BAR
#undef PG8_SCHED
}

constexpr float V8_MUL = 16.0f;
__device__ __forceinline__ unsigned pk4_fp8(float a, float b, float c, float d) { int p = __builtin_amdgcn_cvt_pk_fp8_f32(a, b, 0, false); p = __builtin_amdgcn_cvt_pk_fp8_f32(c, d, p, true); return (unsigned)p; }
__device__ __forceinline__ u32x4 pair_rows16(u32x2 wa, u32x2 wb) {
    auto rx = __builtin_amdgcn_permlane16_swap(wa.x, wb.x, false, false); auto ry = __builtin_amdgcn_permlane16_swap(wa.y, wb.y, false, false);
    u32x4 o; o.x = rx[0]; o.y = ry[0]; o.z = rx[1]; o.w = ry[1]; return o; }
template <bool I8> struct EpiProjT {
    static constexpr bool PERM = true, HAS_PRE = I8;
    bf16_t* P; bf16_t* QKV; float sc; const float* rs; const float* cs;
    __device__ __forceinline__ f32x4 val(const f32x4& a, const f32x4& scl) const {
        if (I8) { const i32x4 ai = __builtin_bit_cast(i32x4, a); return (f32x4){(float)ai[0], (float)ai[1], (float)ai[2], (float)ai[3]} * scl; }
        return a * scl; }
    __device__ __forceinline__ const float* pre_src(const Unit& u, int tid) const { return tid < 256 ? rs + u.pm * BM + tid : cs + u.pn * BM + tid - 256; }
    __device__ __forceinline__ void run(const f32x4 (&acc)[2][2][4][2], const Unit& u, int wr, int wc, int fr, int fq, const LAS float* tab) const { body(acc, u, wr, wc, fr, fq, tab); }
    __device__ __forceinline__ void operator()(const f32x4 (&acc)[2][2][4][2], const Unit& u, int wr, int wc, int fr, int fq) const { body(acc, u, wr, wc, fr, fq, nullptr); }
    __device__ __forceinline__ void body(const f32x4 (&acc)[2][2][4][2], const Unit& u, int wr, int wc, int fr, int fq, const LAS float* tab) const {
        const int row0 = u.pm * BM + wr * 64 + fr, col0 = u.pn * BM + wc * 32 + 8 * fq;
        const int mode = u.pn < 36 ? 0 : (u.pn < 44 ? 1 : 2);
        f32x4 cs0[2], cs1[2];
#pragma unroll
        for (int bj = 0; bj < 2; ++bj) { if (I8) { cs0[bj] = *(const LAS f32x4*)(tab + 256 + wc * 32 + 8 * fq + bj * HALF); cs1[bj] = *(const LAS f32x4*)(tab + 256 + wc * 32 + 8 * fq + bj * HALF + 4); } else { cs0[bj] = (f32x4){sc, sc, sc, sc}; cs1[bj] = cs0[bj]; } }
        float rsv[2][4];
#pragma unroll
        for (int ai = 0; ai < 2; ++ai)
#pragma unroll
            for (int m = 0; m < 4; ++m) rsv[ai][m] = I8 ? tab[wr * 64 + fr + ai * HALF + m * 16] : 1.0f;
        if (mode == 0) {
            const int which = u.pn / 12, rem = u.pn % 12, g = rem >> 2, hp = rem & 3, lr = 2 * g;
            constexpr size_t WHQ = (size_t)3 * 8 * 8 * 2048 * 128;
#pragma unroll
            for (int ai = 0; ai < 2; ++ai) { u32x2 v8w[4][2]; int v8p[4], v8b[4];
#pragma unroll
                for (int m = 0; m < 4; ++m) { const int t = row0 + ai * HALF + m * 16, b = t >> 11, pos = t & 2047;
                    const int pp = ((pos & ((1 << lr) - 1)) << (11 - lr)) + (pos >> lr);
#pragma unroll
                    for (int bj = 0; bj < 2; ++bj) { const f32x4 v0 = val(acc[ai][bj][m][0], cs0[bj] * rsv[ai][m]), v1 = val(acc[ai][bj][m][1], cs1[bj] * rsv[ai][m]);
                        if (true) {
                            v8w[m][bj].x = pk4_fp8(v0[0] * V8_MUL, v0[1] * V8_MUL, v0[2] * V8_MUL, v0[3] * V8_MUL); v8w[m][bj].y = pk4_fp8(v1[0] * V8_MUL, v1[1] * V8_MUL, v1[2] * V8_MUL, v1[3] * V8_MUL);
                            v8p[m] = pp; v8b[m] = b;
                            if (m & 1) { const int odd = fq & 1; const u32x4 o = pair_rows16(v8w[m - 1][bj], v8w[m][bj]);
                                *(u32x4*)((unsigned char*)(QKV + which * WHQ) + ((((size_t)g * 8 + hp * 2 + bj) * 8 + v8b[m - 1 + odd]) * 2048 + v8p[m - 1 + odd]) * 128 + wc * 32 + 8 * fq - 8 * odd) = o; }
                            continue; }
                        u32x4 w; w.x = cvt_pk_bf16(v0[0], v0[1]); w.y = cvt_pk_bf16(v0[2], v0[3]); w.z = cvt_pk_bf16(v1[0], v1[1]); w.w = cvt_pk_bf16(v1[2], v1[3]);
                        *(u32x4*)(QKV + ((((size_t)(which * 3 + g) * 8 + hp * 2 + bj) * 8 + b) * 2048 + pp) * 128 + wc * 32 + 8 * fq) = w; } } }
            return;
        }
        if (mode == 1) tail<1>(acc, row0, col0, cs0, cs1, rsv); else tail<2>(acc, row0, col0, cs0, cs1, rsv);
    }
    template <int MODE> __device__ __forceinline__ void tail(const f32x4 (&acc)[2][2][4][2], int row0, int col0, const f32x4 (&cs0)[2], const f32x4 (&cs1)[2], const float (&rsv)[2][4]) const {
#pragma unroll
        for (int ai = 0; ai < 2; ++ai)
#pragma unroll
            for (int m = 0; m < 4; ++m) { bf16_t* rowp = P + (size_t)(row0 + ai * HALF + m * 16) * INC + col0;
#pragma unroll
                for (int bj = 0; bj < 2; ++bj) { constexpr float C1 = -1.5957691216057308f * 1.4426950408889634f, C3 = 0.044715f * C1, CS = MODE == 1 ? 1.0f : -1.4426950408889634f;
                    f32x4 v0 = val(acc[ai][bj][m][0], cs0[bj] * (rsv[ai][m] * CS)), v1 = val(acc[ai][bj][m][1], cs1[bj] * (rsv[ai][m] * CS));
                    f32x4 e0, e1;
                    if (MODE == 1) { e0 = (v0 * v0 * C3 + C1) * v0; e1 = (v1 * v1 * C3 + C1) * v1; } else { e0 = v0; e1 = v1; }
#pragma unroll
                    for (int j = 0; j < 4; ++j) { e0[j] = __builtin_amdgcn_exp2f(e0[j]); e1[j] = __builtin_amdgcn_exp2f(e1[j]); }
                    e0 = e0 + 1.0f; e1 = e1 + 1.0f;
#pragma unroll
                    for (int j = 0; j < 4; ++j) { e0[j] = __builtin_amdgcn_rcpf(e0[j]); e1[j] = __builtin_amdgcn_rcpf(e1[j]); }
                    if (MODE == 1) { v0 = v0 * e0; v1 = v1 * e1; } else { v0 = e0; v1 = e1; }
                    u32x4 w; w.x = cvt_pk_bf16(v0[0], v0[1]); w.y = cvt_pk_bf16(v0[2], v0[3]); w.z = cvt_pk_bf16(v1[0], v1[1]); w.w = cvt_pk_bf16(v1[2], v1[3]);
                    *(u32x4*)(rowp + bj * HALF) = w; } }
    }
};
typedef EpiProjT<false> EpiProj;
template <int BR> struct EpiBranch {
    static constexpr bool PERM = true, HAS_PRE = false;
    const bf16_t* P; bf16_t* t0; bf16_t* mp; float sc;
    __device__ __forceinline__ void operator()(const f32x4 (&acc)[2][2][4][2], const Unit& u, int wr, int wc, int fr, int fq) const {
        const int row0 = u.pm * BM + wr * 64 + fr, col0 = u.pn * BM + wc * 32 + 8 * fq;
#pragma unroll
        for (int ai = 0; ai < 2; ++ai) {
            u32x4 gv[4][2], pv[4][2];
#pragma unroll
            for (int m = 0; m < 4; ++m) { const size_t row = (size_t)(row0 + ai * HALF + m * 16);
#pragma unroll
                for (int bj = 0; bj < 2; ++bj) { const int col = col0 + bj * HALF; gv[m][bj] = *(const u32x4*)(P + row * INC + O_G + BR * DM + col);
                    if (BR == 1) { if (T0_FP8) { const u32x2 q = *(const u32x2*)((const unsigned char*)t0 + row * DM + col); pv[m][bj].x = q.x; pv[m][bj].y = q.y; } else pv[m][bj] = *(const u32x4*)(t0 + row * DM + col); } } }
            u32x2 wm8[4][2];
#pragma unroll
            for (int m = 0; m < 4; ++m) { const size_t row = (size_t)(row0 + ai * HALF + m * 16);
#pragma unroll
                for (int bj = 0; bj < 2; ++bj) { const int col = col0 + bj * HALF; const u32x4 g = gv[m][bj];
                    f32x4 v0 = acc[ai][bj][m][0] * sc, v1 = acc[ai][bj][m][1] * sc;
                    v0[0] *= bf_lo(g.x); v0[1] *= bf_hi(g.x); v0[2] *= bf_lo(g.y); v0[3] *= bf_hi(g.y);
                    v1[0] *= bf_lo(g.z); v1[1] *= bf_hi(g.z); v1[2] *= bf_lo(g.w); v1[3] *= bf_hi(g.w);
                    if (BR == 1) { const u32x4 p = pv[m][bj];
                        if (T0_FP8) { const f32x2 a = __builtin_amdgcn_cvt_pk_f32_fp8((int)p.x, false), b = __builtin_amdgcn_cvt_pk_f32_fp8((int)p.x, true), c = __builtin_amdgcn_cvt_pk_f32_fp8((int)p.y, false), d = __builtin_amdgcn_cvt_pk_f32_fp8((int)p.y, true);
                            v0[0] += a[0] * (1.0f / T0_MUL); v0[1] += a[1] * (1.0f / T0_MUL); v0[2] += b[0] * (1.0f / T0_MUL); v0[3] += b[1] * (1.0f / T0_MUL);
                            v1[0] += c[0] * (1.0f / T0_MUL); v1[1] += c[1] * (1.0f / T0_MUL); v1[2] += d[0] * (1.0f / T0_MUL); v1[3] += d[1] * (1.0f / T0_MUL); }
                        else {
                        v0[0] += bf_lo(p.x); v0[1] += bf_hi(p.x); v0[2] += bf_lo(p.y); v0[3] += bf_hi(p.y);
                        v1[0] += bf_lo(p.z); v1[1] += bf_hi(p.z); v1[2] += bf_lo(p.w); v1[3] += bf_hi(p.w); } }
                    if ((BR == 1 && P5_FP8) || (BR == 0 && T0_FP8)) { constexpr float OM = BR == 1 ? MP_MUL : T0_MUL;
                        wm8[m][bj].x = pk4_fp8(v0[0] * OM, v0[1] * OM, v0[2] * OM, v0[3] * OM); wm8[m][bj].y = pk4_fp8(v1[0] * OM, v1[1] * OM, v1[2] * OM, v1[3] * OM);
                        if (m & 1) { const int odd = fq & 1; const u32x4 o = pair_rows16(wm8[m - 1][bj], wm8[m][bj]);
                            *(u32x4*)((unsigned char*)(BR == 1 ? mp : t0) + (size_t)(row0 + ai * HALF + (m - 1 + odd) * 16) * DM + col - 8 * odd) = o; } }
                    else { u32x4 w; w.x = cvt_pk_bf16(v0[0], v0[1]); w.y = cvt_pk_bf16(v0[2], v0[3]); w.z = cvt_pk_bf16(v1[0], v1[1]); w.w = cvt_pk_bf16(v1[2], v1[3]);
                        *(u32x4*)((BR == 0 ? t0 : mp) + row * DM + col) = w; } } } }
    }
};
struct EpiOut {
    static constexpr bool PERM = false, HAS_PRE = false;
    const float* x; float* r1; float sc;
    __device__ __forceinline__ void operator()(const f32x4 (&acc)[2][2][4][2], const Unit& u, int wr, int wc, int fr, int fq) const {
        const int row0 = u.pm * BM + wr * 64 + fr, col0 = u.pn * BM + wc * 32 + 4 * fq;
#pragma unroll
        for (int ai = 0; ai < 2; ++ai) {
            f32x4 xv[4][2][2];
#pragma unroll
            for (int m = 0; m < 4; ++m) { const size_t off = (size_t)(row0 + ai * HALF + m * 16) * DM + col0;
#pragma unroll
                for (int bj = 0; bj < 2; ++bj)
#pragma unroll
                    for (int n = 0; n < 2; ++n) xv[m][bj][n] = __builtin_nontemporal_load((const f32x4*)(x + off + bj * HALF + n * 16)); }
#pragma unroll
            for (int m = 0; m < 4; ++m) { const size_t off = (size_t)(row0 + ai * HALF + m * 16) * DM + col0;
#pragma unroll
                for (int bj = 0; bj < 2; ++bj) {
                    u32x2 w[2];
#pragma unroll
                    for (int n = 0; n < 2; ++n) { const f32x4 r = xv[m][bj][n] * ALPHA + acc[ai][bj][m][n] * sc; w[n].x = cvt_pk_bf16(r[0], r[1]); w[n].y = cvt_pk_bf16(r[2], r[3]); }
                    const int odd = fq & 1; const u32x4 o = pair_rows16(w[0], w[1]);
                    *(u32x4*)((bf16_t*)r1 + off + bj * HALF + 16 * odd - 4 * odd) = o; } } }
    }
};
__device__ __forceinline__ unsigned pack4_fp8(float a, float b, float c, float d) { int p = __builtin_amdgcn_cvt_pk_fp8_f32(a, b, 0, false); p = __builtin_amdgcn_cvt_pk_fp8_f32(c, d, p, true); return (unsigned)p; }
struct EpiGU {
    static constexpr bool PERM = true, HAS_PRE = true;
    const float* bgu; unsigned char* act; const LAS int* tpre;
    __device__ __forceinline__ const float* pre_src(const Unit& u, int tid) const {
        return bgu + (size_t)u.e * 2 * EH + ((tid >> 7) & 1) * EH + u.pn * HALF + (tid & 127); }
    __device__ __forceinline__ void run(const f32x4 (&acc)[2][2][4][2], const Unit& u, int wr, int wc, int fr, int fq, const LAS float* tab) const {
        const int row0 = (tpre[u.e] + u.pm) * BM + wr * 64 + fr, col0 = u.pn * HALF + wc * 32 + 8 * fq;
        const LAS float* bg = tab + wc * 32 + 8 * fq;
        const f32x4 bg0 = *(const LAS f32x4*)(bg), bg1 = *(const LAS f32x4*)(bg + 4), bl0 = *(const LAS f32x4*)(bg + HALF) + 1.0f, bl1 = *(const LAS f32x4*)(bg + HALF + 4) + 1.0f;
        constexpr float KS = -1.702f * 1.4426950408889634f;
        const int odd = fq & 1;
#pragma unroll
        for (int ai = 0; ai < 2; ++ai) { u32x2 wm[4];
#pragma unroll
            for (int m = 0; m < 4; ++m) {
                f32x4 ga = acc[ai][0][m][0] * W8_INV + bg0, gb = acc[ai][0][m][1] * W8_INV + bg1, la = acc[ai][1][m][0] * W8_INV + bl0, lb = acc[ai][1][m][1] * W8_INV + bl1;
#pragma unroll
                for (int j = 0; j < 4; ++j) { ga[j] = fminf(ga[j], 7.0f); gb[j] = fminf(gb[j], 7.0f); la[j] = __builtin_amdgcn_fmed3f(la[j], -6.0f, 8.0f); lb[j] = __builtin_amdgcn_fmed3f(lb[j], -6.0f, 8.0f); }
                f32x4 ea = ga * KS, eb = gb * KS;
#pragma unroll
                for (int j = 0; j < 4; ++j) { ea[j] = __builtin_amdgcn_exp2f(ea[j]); eb[j] = __builtin_amdgcn_exp2f(eb[j]); }
                ea = ea + 1.0f; eb = eb + 1.0f;
#pragma unroll
                for (int j = 0; j < 4; ++j) { ea[j] = __builtin_amdgcn_rcpf(ea[j]); eb[j] = __builtin_amdgcn_rcpf(eb[j]); }
                const f32x4 o0 = ga * ea * la, o1 = gb * eb * lb;
                wm[m].x = pack4_fp8(o0[0], o0[1], o0[2], o0[3]); wm[m].y = pack4_fp8(o1[0], o1[1], o1[2], o1[3]);
                if (m & 1) { const u32x4 o = pair_rows16(wm[m - 1], wm[m]);
                    *(u32x4*)(act + (size_t)(row0 + ai * HALF + (m - 1 + odd) * 16) * EH + col0 - 8 * odd) = o; } } }
    }
};
struct EpiDown {
    static constexpr bool PERM = true, HAS_PRE = true;
    const float* bdn; unsigned char* y; const float* slot_gate; const LAS int* tpre; const LAS int* cnt;
    __device__ __forceinline__ const float* pre_src(const Unit& u, int tid) const {
        return tid < 256 ? bdn + (size_t)u.e * DM + u.pn * BM + tid : slot_gate + (size_t)u.e * T + u.pm * BM + tid - 256; }
    __device__ __forceinline__ void run(const f32x4 (&acc)[2][2][4][2], const Unit& u, int wr, int wc, int fr, int fq, const LAS float* tab) const {
        const int lrow0 = u.pm * BM + wr * 64 + fr, row0 = tpre[u.e] * BM + lrow0, col0 = u.pn * BM + wc * 32 + 8 * fq;
        f32x4 bv[2][2];
#pragma unroll
        for (int bj = 0; bj < 2; ++bj)
#pragma unroll
            for (int n = 0; n < 2; ++n) bv[bj][n] = *(const LAS f32x4*)(tab + wc * 32 + 8 * fq + bj * HALF + 4 * n);
        float gts[2][4];
#pragma unroll
        for (int ai = 0; ai < 2; ++ai)
#pragma unroll
            for (int m = 0; m < 4; ++m) { const int r = wr * 64 + fr + ai * HALF + m * 16; const float gv = tab[256 + r]; gts[ai][m] = (u.pm * BM + r < cnt[u.e]) ? gv * Y_MUL : 0.f; }
        const int odd = fq & 1;
#pragma unroll
        for (int ai = 0; ai < 2; ++ai) { u32x2 wm[4][2];
#pragma unroll
            for (int m = 0; m < 4; ++m) { const float gt = gts[ai][m];
#pragma unroll
                for (int bj = 0; bj < 2; ++bj) { const f32x4 v0 = (acc[ai][bj][m][0] * W8_INV + bv[bj][0]) * gt, v1 = (acc[ai][bj][m][1] * W8_INV + bv[bj][1]) * gt;
                    wm[m][bj].x = pack4_fp8(v0[0], v0[1], v0[2], v0[3]); wm[m][bj].y = pack4_fp8(v1[0], v1[1], v1[2], v1[3]);
                    if (m & 1) { const u32x4 o = pair_rows16(wm[m - 1][bj], wm[m][bj]);
                        *(u32x4*)(y + (size_t)(row0 + ai * HALF + (m - 1 + odd) * 16) * DM + col0 - 8 * odd + bj * HALF) = o; } } } }
    }
};
}

struct Args { const float* in[19]; float* out; unsigned char* ws; int ph_lo, ph_hi; };
static_assert(sizeof(Args) == 19 * 8 + 8 + 8 + 8, "Args has no padding");
enum { I_X = 0, I_WIN, I_RELB, I_SLNG, I_SLNB, I_SW, I_SB, I_WBR, I_WOUT, I_LN1G, I_LN1B, I_WR, I_BR, I_WGU, I_BGU, I_WDN, I_BDN, I_LN2G, I_LN2B };

__device__ __forceinline__ unsigned f2bf(float f) { unsigned u = __builtin_bit_cast(unsigned, f); return (u + 0x7fffu + ((u >> 16) & 1u)) >> 16; }
#ifndef CVT_NT
#define CVT_NT 1
#endif
#if CVT_NT
#define CVT_LD(p) __builtin_nontemporal_load(p)
#define CVT_ST(v, p) __builtin_nontemporal_store(v, p)
#else
#define CVT_LD(p) (*(p))
#define CVT_ST(v, p) (*(p) = (v))
#endif
__device__ __forceinline__ unsigned pk4_fp8(float a, float b, float c, float d) { int p = __builtin_amdgcn_cvt_pk_fp8_f32(a, b, 0, false); p = __builtin_amdgcn_cvt_pk_fp8_f32(c, d, p, true); return (unsigned)p; }
struct CvtJob { const float* W; bf16_t* WT; int K, N, perm, ld; };
__device__ __forceinline__ void cvt_load(const CvtJob& j, int it, int lane, f32x4 (&v)[16]) {
    const int nbk = j.N >> 6, per = (j.K >> 6) * nbk; const int mat = it / per, rem = it - mat * per, kb = rem / nbk, nb = rem - kb * nbk;
    const int ld = j.ld ? j.ld : j.N;
    const float* src = j.W + (size_t)mat * j.K * j.N + (size_t)(kb * 64 + 2 * (lane >> 4)) * ld + nb * 64 + 4 * (lane & 15);
#pragma unroll
    for (int i = 0; i < 8; ++i)
#pragma unroll
        for (int b = 0; b < 2; ++b) v[2 * i + b] = CVT_LD((const f32x4*)(src + (size_t)(8 * i + b) * ld));
}
__device__ __forceinline__ void cvt_store(const CvtJob& j, int it, int lane, const f32x4 (&v)[16], LAS unsigned char* scr) {
    const int nbk = j.N >> 6, per = (j.K >> 6) * nbk; const int mat = it / per, rem = it - mat * per, kb = rem / nbk, nb = rem - kb * nbk;
    const int nq = lane & 15, g = lane >> 4;
#pragma unroll
    for (int i = 0; i < 8; ++i)
#pragma unroll
        for (int c = 0; c < 4; ++c) { const int d = 4 * i + g; *(LAS unsigned*)(scr + (4 * nq + c) * 128 + ((d ^ ((nq & 7) << 2)) << 2)) = cvt_pk_bf16(v[2 * i][c], v[2 * i + 1][c]); }
    LDS_WAIT();
    const int n0 = nb * 64; const int drow0 = j.perm ? ((n0 & 2047) >> 7) * 256 + (n0 >> 11) * 128 + (n0 & 127) : n0;
    bf16_t* dst = j.WT + (size_t)mat * j.K * j.N + (size_t)drow0 * j.K + kb * 64;
#pragma unroll
    for (int jj = 0; jj < 8; ++jj) { const int id = lane + 64 * jj, n = id >> 3, kc = id & 7;
        const u32x4 o = *(const LAS u32x4*)(scr + n * 128 + ((kc ^ ((n >> 2) & 7)) << 4));
        CVT_ST(o, (u32x4*)(dst + (size_t)n * j.K + 8 * kc)); }
    LDS_WAIT();
}
template <int K, int N, int LD, int PERM>
__device__ __forceinline__ void cvt8_load(const float* W, int it, int lane, f32x4 (&v)[16]) {
    constexpr int NBK = N / 32, PER = (K / 128) * NBK;
    const int mat = it / PER, rem = it - mat * PER, kb = rem / NBK, nb = rem - kb * NBK;
    const char* ub = (const char*)(W + (size_t)mat * K * N + (size_t)kb * 128 * LD + nb * 32);
    const unsigned loff = (unsigned)((4 * (lane >> 3)) * LD + 4 * (lane & 7)) * 4u;
#pragma unroll
    for (int i = 0; i < 4; ++i)
#pragma unroll
        for (int b = 0; b < 4; ++b) v[4 * i + b] = CVT_LD((const f32x4*)(ub + (size_t)(32 * i + b) * LD * 4 + loff));
}
template <int K, int N, int LD, int PERM>
__device__ __forceinline__ void cvt8_store(unsigned char* WT, int it, int lane, const f32x4 (&v)[16], LAS unsigned char* scr) {
    constexpr int NBK = N / 32, PER = (K / 128) * NBK;
    const int mat = it / PER, rem = it - mat * PER, kb = rem / NBK, nb = rem - kb * NBK;
    const int nq = lane & 7, gk = lane >> 3;
    LAS unsigned char* wp = scr + (4 * nq) * 128 + (gk << 2);
#pragma unroll
    for (int i = 0; i < 4; ++i) { const f32x4 s0 = v[4 * i] * pg8::W8_MUL, s1 = v[4 * i + 1] * pg8::W8_MUL, s2 = v[4 * i + 2] * pg8::W8_MUL, s3 = v[4 * i + 3] * pg8::W8_MUL;
        const int xo = ((i ^ (nq & 3)) << 5);
#pragma unroll
        for (int c = 0; c < 4; ++c) *(LAS unsigned*)(wp + c * 128 + xo) = pk4_fp8(s0[c], s1[c], s2[c], s3[c]); }
    LDS_WAIT();
    const int n0 = nb * 32; const int drow0 = PERM ? ((n0 & 2047) >> 7) * 256 + (n0 >> 11) * 128 + (n0 & 127) : n0;
    unsigned char* ub = WT + (size_t)mat * K * N + (size_t)drow0 * K + kb * 128;
    const unsigned soff = (unsigned)((lane >> 3) * K + 16 * (lane & 7));
    const int kc = lane & 7;
#pragma unroll
    for (int jj = 0; jj < 4; ++jj) { const int n = (lane >> 3) + 8 * jj;
        const u32x4 o = *(const LAS u32x4*)(scr + n * 128 + ((kc ^ (((n >> 2) & 3) << 1)) << 4));
        CVT_ST(o, (u32x4*)(ub + (size_t)jj * 8 * K + soff)); }
    LDS_WAIT();
}
template <int K, int N, int LD, int PERM>
__device__ __forceinline__ void cvt8_run(const float* W, unsigned char* WT, int ntiles_, int gw, int nw, int lane_, LAS unsigned char* scr, int rep = 1) {
    int lane = lane_; asm volatile("" : "+v"(lane)); const int ntiles = ntiles_ * rep;
    f32x4 va[16], vb[16];
    int it = gw;
    if (it < ntiles) cvt8_load<K, N, LD, PERM>(W, it % ntiles_, lane, va);
    while (it < ntiles) {
        const int it1 = it + nw;
        if (it1 < ntiles) cvt8_load<K, N, LD, PERM>(W, it1 % ntiles_, lane, vb);
        cvt8_store<K, N, LD, PERM>(WT, it % ntiles_, lane, va, scr);
        if (it1 >= ntiles) break;
        const int it2 = it1 + nw;
        if (it2 < ntiles) cvt8_load<K, N, LD, PERM>(W, it2 % ntiles_, lane, va);
        cvt8_store<K, N, LD, PERM>(WT, it1 % ntiles_, lane, vb, scr);
        it = it2;
    }
}
template <int K, int N, int LD, int PERM>
__device__ __forceinline__ void cvt8s_load(const float* W, int st, int wave, int lane, f32x4 (&v)[16]) {
    constexpr int NBK = N / 256, PER = (K / 128) * NBK;
    const int mat = st / PER, rem = st - mat * PER, kb = rem / NBK, nb = rem - kb * NBK;
    const char* ub = (const char*)(W + (size_t)mat * K * N + (size_t)(kb * 128 + 16 * wave) * LD + nb * 256);
#pragma unroll
    for (int j = 0; j < 16; ++j) v[j] = CVT_LD((const f32x4*)(ub + (size_t)j * LD * 4 + lane * 16));
}
template <int K, int N, int LD, int PERM>
__device__ __forceinline__ void cvt8s_store(unsigned char* WT, int st, int tid, int wave, int lane, const f32x4 (&v)[16], LAS unsigned char* img) {
    constexpr int NBK = N / 256, PER = (K / 128) * NBK;
    const int mat = st / PER, rem = st - mat * PER, kb = rem / NBK, nb = rem - kb * NBK;
    LAS unsigned char* wp = img + (4 * lane) * 144 + 16 * (wave ^ ((lane >> 2) & 7));
#pragma unroll
    for (int c = 0; c < 4; ++c) { u32x4 o;
        o.x = pk4_fp8(v[0][c] * pg8::W8_MUL, v[1][c] * pg8::W8_MUL, v[2][c] * pg8::W8_MUL, v[3][c] * pg8::W8_MUL); o.y = pk4_fp8(v[4][c] * pg8::W8_MUL, v[5][c] * pg8::W8_MUL, v[6][c] * pg8::W8_MUL, v[7][c] * pg8::W8_MUL);
        o.z = pk4_fp8(v[8][c] * pg8::W8_MUL, v[9][c] * pg8::W8_MUL, v[10][c] * pg8::W8_MUL, v[11][c] * pg8::W8_MUL); o.w = pk4_fp8(v[12][c] * pg8::W8_MUL, v[13][c] * pg8::W8_MUL, v[14][c] * pg8::W8_MUL, v[15][c] * pg8::W8_MUL);
        *(LAS u32x4*)(wp + c * 144) = o; }
    __syncthreads();
    unsigned char* ub = WT + (size_t)mat * K * N + kb * 128;
#pragma unroll
    for (int jj = 0; jj < 4; ++jj) { const int id = tid + 512 * jj, n = id >> 3, pc = id & 7, kc = pc ^ ((n >> 4) & 7);
        const int ng = nb * 256 + n; const int drow = PERM ? ((ng & 2047) >> 7) * 256 + (ng >> 11) * 128 + (ng & 127) : ng;
        const u32x4 o = *(const LAS u32x4*)(img + n * 144 + 16 * pc);
        CVT_ST(o, (u32x4*)(ub + (size_t)drow * K + 16 * kc)); }
}
template <int K, int N, int LD, int PERM>
__device__ __forceinline__ void cvt8s_run(const float* W, unsigned char* WT, int nst_, int first, int step, int tid_, int wave, LAS unsigned char* img, int rep = 1) {
    int tid = tid_; asm volatile("" : "+v"(tid)); const int lane = tid & 63; const int nst = nst_ * rep;
    f32x4 va[16], vb[16];
    int st = first;
    if (st < nst) cvt8s_load<K, N, LD, PERM>(W, st % nst_, wave, lane, va);
    while (st < nst) {
        const int s1 = st + step;
        if (s1 < nst) cvt8s_load<K, N, LD, PERM>(W, s1 % nst_, wave, lane, vb);
        cvt8s_store<K, N, LD, PERM>(WT, st % nst_, tid, wave, lane, va, img);
        if (s1 >= nst) break;
        const int s2 = s1 + step;
        if (s2 < nst) cvt8s_load<K, N, LD, PERM>(W, s2 % nst_, wave, lane, va);
        cvt8s_store<K, N, LD, PERM>(WT, s1 % nst_, tid, wave, lane, vb, img + 36864);
        st = s2;
    }
    __syncthreads();
}
__device__ __forceinline__ void cvt_run(const CvtJob& j, int ntiles, int gw, int nw, int lane, LAS unsigned char* scr) {
    f32x4 va[16], vb[16];
    int it = gw;
    if (it < ntiles) cvt_load(j, it, lane, va);
    while (it < ntiles) {
        const int it1 = it + nw;
        if (it1 < ntiles) cvt_load(j, it1, lane, vb);
        cvt_store(j, it, lane, va, scr);
        if (it1 >= ntiles) break;
        const int it2 = it1 + nw;
        if (it2 < ntiles) cvt_load(j, it2, lane, va);
        cvt_store(j, it1, lane, vb, scr);
        it = it2;
    }
}

__device__ __forceinline__ unsigned pack4_i8(float a, float b, float c, float d) {
    const int ia = (int)__builtin_rintf(a), ib = (int)__builtin_rintf(b), ic = (int)__builtin_rintf(c), id = (int)__builtin_rintf(d);
    return (unsigned)(ia & 0xff) | ((unsigned)(ib & 0xff) << 8) | ((unsigned)(ic & 0xff) << 16) | ((unsigned)id << 24);
}
__device__ __forceinline__ void x_to_i8(const float* x, unsigned* xq, float* xs, int gw, int ngw, int lane) {
    for (int t = gw; t < T; t += ngw) {
        f32x4 v[8]; float am = 0.f;
#pragma unroll
        for (int i = 0; i < 8; ++i) { v[i] = *(const f32x4*)(x + (size_t)t * DM + 4 * lane + 256 * i); am = fmaxf(am, fmaxf(fmaxf(fabsf(v[i][0]), fabsf(v[i][1])), fmaxf(fabsf(v[i][2]), fabsf(v[i][3])))); }
        am = wave_max(am); const float inv = am > 0.f ? 127.0f / am : 0.f;
#pragma unroll
        for (int i = 0; i < 8; ++i) xq[((size_t)t * DM + 4 * lane + 256 * i) >> 2] = pack4_i8(v[i][0] * inv, v[i][1] * inv, v[i][2] * inv, v[i][3] * inv);
        if (lane == 0) xs[t] = am * (1.0f / 127.0f);
    }
}
template <int LD>
__device__ __forceinline__ void cvt_i8_strips(const float* W, unsigned char* Wq, float* cscale, int nstrips, int first, int step, int tid_, LAS unsigned char* lds) {
    int tid = tid_; asm volatile("" : "+v"(tid));
    LAS float* red = (LAS float*)lds; LAS unsigned char* img = lds + 8192; LAS float* sinv = (LAS float*)(lds + 8192 + 65536);
    const int c4 = tid & 7, kq = tid >> 3;
    for (int st = first; st < nstrips; st += step) {
        const int n0 = 32 * st;
        f32x4 v[8][4];
        const float* src = W + (size_t)(4 * kq) * LD + n0 + 4 * c4;
#pragma unroll
        for (int i = 0; i < 8; ++i)
#pragma unroll
            for (int j = 0; j < 4; ++j) v[i][j] = CVT_LD((const f32x4*)(src + (size_t)(256 * i + j) * LD));
        f32x4 m = (f32x4){0.f, 0.f, 0.f, 0.f};
#pragma unroll
        for (int i = 0; i < 8; ++i)
#pragma unroll
            for (int j = 0; j < 4; ++j) m = __builtin_elementwise_max(m, __builtin_elementwise_abs(v[i][j]));
        *(LAS f32x4*)(red + kq * 32 + 4 * c4) = m;
        __syncthreads();
        if (tid < 32) { float mx = 0.f;
#pragma unroll 8
            for (int r = 0; r < 64; ++r) mx = fmaxf(mx, red[r * 32 + tid]);
            cscale[n0 + tid] = mx * (1.0f / 127.0f); sinv[tid] = mx > 0.f ? 127.0f / mx : 0.f; }
        __syncthreads();
        const f32x4 iv = *(const LAS f32x4*)(sinv + 4 * c4);
#pragma unroll
        for (int i = 0; i < 8; ++i)
#pragma unroll
            for (int c = 0; c < 4; ++c) { const int d = kq + 64 * i;
                *(LAS unsigned*)(img + (4 * c4 + c) * 2048 + ((d ^ (c4 << 3)) << 2)) = pack4_i8(v[i][0][c] * iv[c], v[i][1][c] * iv[c], v[i][2][c] * iv[c], v[i][3][c] * iv[c]); }
        __syncthreads();
#pragma unroll
        for (int jj = 0; jj < 8; ++jj) { const int id = tid + 512 * jj, n = id >> 7, q = id & 127;
            const u32x4 o = *(const LAS u32x4*)(img + n * 2048 + ((q ^ ((n >> 2) << 1)) << 4));
            CVT_ST(o, (u32x4*)(Wq + (size_t)(n0 + n) * 2048 + 16 * q)); }
        __syncthreads();
    }
}

__device__ __forceinline__ void p0_prologue(const Args& a, LAS unsigned char* lds, int vcu, int G, int wave, int lane) {
    unsigned char* ws = a.ws;
    LAS unsigned char* scr = lds + wave * 8192;
    const int gw = vcu * NWAVES + wave, NGW = G * NWAVES;
#if P1_I8
    cvt_i8_strips<INC>(a.in[I_WIN], ws + WS_WIN, (float*)(ws + WS_WCS), INC / 32, vcu, G, (int)threadIdx.x, lds);
    x_to_i8(a.in[I_X], (unsigned*)(ws + WS_XB), (float*)(ws + WS_XS), gw, NGW, lane);
#elif P1_FP8
    cvt8s_run<DM, INC, INC, 0>(a.in[I_WIN], ws + WS_WIN, (DM / 128) * (INC / 256), vcu, G, (int)threadIdx.x, wave, lds);
#else
    { CvtJob j{a.in[I_WIN], (bf16_t*)(ws + WS_WIN), DM, INC, 0, 0}; cvt_run(j, (DM / 64) * (INC / 64), gw, NGW, lane, scr); }
#endif
#if CONV1_WGS == 0
    { CvtJob j{a.in[I_WGU], (bf16_t*)(ws + WS_WGU), DM, 2 * EH, 1, 0}; cvt_run(j, NE * (DM / 64) * (2 * EH / 64), gw, NGW, lane, scr); }
#endif
#if CONV2_WGS == 0
    { CvtJob j{a.in[I_WDN], (bf16_t*)(ws + WS_WDN), EH, DM, 0, 0}; cvt_run(j, NE * (EH / 64) * (DM / 64), gw, NGW, lane, scr); }
#endif
    if (vcu == 0) {
        LAS float* pred = (LAS float*)(lds + 65536); const int tid = threadIdx.x, e = tid & 31, part = tid >> 5; float pcg = 0.f, pcb = 0.f;
        const float* Wr = a.in[I_WR]; const float* g1 = a.in[I_LN1G]; const float* b1 = a.in[I_LN1B];
        for (int jj = 0; jj < 128; ++jj) { const int k = part * 128 + jj; const float w = Wr[(size_t)k * NE + e]; pcg += g1[k] * w; pcb += b1[k] * w; }
        pred[part * 32 + e] = pcg; pred[512 + part * 32 + e] = pcb;
        __syncthreads();
        if (tid < 32) { float sg = 0.f, sb_ = a.in[I_BR][tid];
            for (int pp = 0; pp < 16; ++pp) { sg += pred[pp * 32 + tid]; sb_ += pred[512 + pp * 32 + tid]; }
            ((float*)(ws + WS_CGB))[tid] = sg; ((float*)(ws + WS_CGB))[32 + tid] = sb_; }
    }
    const f32x4* x4 = (const f32x4*)a.in[I_X]; u32x2* xb = (u32x2*)(ws + WS_XB);
    const size_t n4 = (size_t)T * DM / 4, stride = (size_t)G * NTHR;
#if P1_I8
    (void)x4; (void)xb; (void)n4; (void)stride; (void)scr;
#elif P1_FP8
    unsigned* xq = (unsigned*)(ws + WS_XB); u32x2* xb2 = (u32x2*)(ws + WS_H + 64 * MiB);
    for (size_t i = (size_t)vcu * NTHR + threadIdx.x; i < n4; i += stride) { const f32x4 v = x4[i]; xq[i] = pk4_fp8(v[0], v[1], v[2], v[3]);
        u32x2 o; o.x = cvt_pk_bf16(v[0], v[1]); o.y = cvt_pk_bf16(v[2], v[3]); xb2[i] = o; }
    { CvtJob j{a.in[I_WIN] + O_Z, (bf16_t*)(ws + WS_WIN + 32 * MiB), DM, BW, 0, INC}; cvt_run(j, (DM / 64) * (BW / 64), gw, NGW, lane, scr); }
#else
    for (size_t i = (size_t)vcu * NTHR + threadIdx.x; i < n4; i += stride) { const f32x4 v = x4[i]; u32x2 o; o.x = cvt_pk_bf16(v[0], v[1]); o.y = cvt_pk_bf16(v[2], v[3]); xb[i] = o; }
#endif
    {
        bf16_t* wg3 = (bf16_t*)(ws + WS_WG3); const float* Wr = a.in[I_WR]; const float* g1 = a.in[I_LN1G];
        for (int idx = vcu * NTHR + (int)threadIdx.x; idx < NE * DM / 8; idx += G * NTHR) { const int e = idx / (DM / 8), k0 = (idx - e * (DM / 8)) * 8;
            float w[8]; u32x4 hi, mid, lo;
#pragma unroll
            for (int j = 0; j < 8; ++j) w[j] = Wr[(size_t)(k0 + j) * NE + e] * g1[k0 + j];
#pragma unroll
            for (int j = 0; j < 4; ++j) { const unsigned h = cvt_pk_bf16(w[2 * j], w[2 * j + 1]); const float r0 = w[2 * j] - bf_lo(h), r1_ = w[2 * j + 1] - bf_hi(h);
                const unsigned m = cvt_pk_bf16(r0, r1_); const unsigned l = cvt_pk_bf16(r0 - bf_lo(m), r1_ - bf_hi(m)); hi[j] = h; mid[j] = m; lo[j] = l; }
            *(u32x4*)(wg3 + (size_t)e * DM + k0) = hi; *(u32x4*)(wg3 + (size_t)(NE + e) * DM + k0) = mid; *(u32x4*)(wg3 + (size_t)(2 * NE + e) * DM + k0) = lo; } }
}

__device__ __forceinline__ int kimg8(int row, int c16) { return row * 128 + 16 * (c16 ^ (((row >> 1) & 1) | (((row >> 3) & 1) << 2))); }
struct AttnU { int b, g, h, c, n, r; };
__device__ __forceinline__ AttnU attn_decode(int unit) {
    AttnU U; const int v = unit % 3072, w = v / 12, k = v - 12 * w, j = k & 3, q = w & 3; U.g = k >> 2; U.b = w >> 5; U.h = (w >> 2) & 7;
    const int cn = 4 * q + j, lr = 2 * U.g; U.r = 1 << lr; U.c = cn >> (4 - lr); U.n = cn & ((16 >> lr) - 1); return U;
}
constexpr int ABIAS_STR = 212, ABIAS_NINF = 164;
__device__ __forceinline__ void attn_issue(const bf16_t* QKV, const float* rel_bias, const AttnU& U, bool need_prev, int tid, int wave, int lane, u32x4 (&kv)[4], u32x4 (&vv)[4], u32x4 (&Qf)[2], float (&bval)[2]) {
#pragma unroll
    for (int q = 0; q < 2; ++q) {
        const int e = tid + 512 * q, sc = e / ABIAS_STR, k = e - sc * ABIAS_STR, sub = 160 - (k + sc); const bool valid = sub >= 0 && sub <= 128;
        const int dist = U.r * (valid ? sub : 0); int bucket = dist;
        if (dist >= 16) { bucket = 16 + (int)(logf((float)dist * 0.0625f) / 4.852030263919617f * 16.0f); bucket = bucket > 31 ? 31 : bucket; }
        bval[q] = rel_bias[bucket * 24 + U.g * 8 + U.h]; }
    constexpr size_t WH = (size_t)3 * 8 * 8 * 2048 * 128;
    const int L = 2048 / U.r;
    const bf16_t* Qb = QKV + (((size_t)(U.g * 8 + U.h) * 8 + U.b) * 2048 + (size_t)U.c * L) * 128;
    const size_t seq8 = (((size_t)(U.g * 8 + U.h) * 8 + U.b) * 2048 + (size_t)U.c * L) * 128;
    const unsigned char* Kb = (const unsigned char*)(QKV + WH) + seq8; const unsigned char* Vb = (const unsigned char*)(QKV + 2 * WH) + seq8;
#pragma unroll
    for (int i = 0; i < 4; ++i) { const int id = tid + 512 * (i & 1), row = id >> 3, c16 = id & 7; const int m = (U.n - 1) * 128 + (i >> 1) * 128 + row;
        if (i >= 2 || need_prev) { kv[i] = *(const u32x4*)(Kb + (size_t)m * 128 + c16 * 16); vv[i] = *(const u32x4*)(Vb + (size_t)m * 128 + c16 * 16); }
        else { kv[i] = (u32x4){0u, 0u, 0u, 0u}; vv[i] = (u32x4){0u, 0u, 0u, 0u}; } }
    const int mq = U.n * 128 + 16 * wave + (lane & 15);
    const unsigned char* Q8 = (const unsigned char*)QKV + seq8 + (size_t)mq * 128 + 32 * (lane >> 4);
    Qf[0] = *(const u32x4*)Q8; Qf[1] = *(const u32x4*)(Q8 + 16);
}
__device__ __forceinline__ void attn_phase(LAS unsigned char* lds, const bf16_t* P, bf16_t* og, float* lse, const float* rel_bias, int wg, int nwg, int nunits, int tid, int wave, int lane) {
    LAS unsigned char* Kimg = lds; LAS unsigned char* Vimg = lds + 65536; LAS float* biasC = (LAS float*)(lds + TOKTAB_OFF);
    const int upw = (nunits + nwg - 1) / nwg, u0 = wg * upw, u1 = (u0 + upw < nunits) ? u0 + upw : nunits;
    if (u0 >= u1) return;
    u32x4 kv[4], vv[4]; pg8::i32x8 Qf8; u32x4 Qn[2];
    AttnU U = attn_decode(u0);
    float bval[2];
    bool need_prev = U.n > 0; int flip = 0;
    attn_issue(P, rel_bias, U, need_prev, tid, wave, lane, kv, vv, Qn, bval);
    const int qi = lane & 15, gq = lane >> 4, q4 = qi >> 2, p4 = qi & 3;
    for (int unit = u0; unit < u1; ++unit) {
        const int fx = flip << 15; const int flip_c = flip;
#pragma unroll
        for (int i = 0; i < 4; ++i) { const int id = tid + 512 * (i & 1), row = (i >> 1) * 128 + (id >> 3), c16 = id & 7;
            if (i < 2 && !need_prev) continue;
            const int o0 = (int)off_b(row, 2 * c16) + (i < 2 ? fx : -fx), o1 = (int)off_b(row, 2 * c16 + 1) + (i < 2 ? fx : -fx);
            *(LAS u32x4*)(Kimg + kimg8(row, c16) + (i < 2 ? (flip << 14) : -(flip << 14))) = kv[i];
#pragma unroll
            for (int kvsel = 1; kvsel < 2; ++kvsel) { const u32x4 w = kvsel ? vv[i] : kv[i]; u32x4 lo, hi;
                { f32x2 a = __builtin_amdgcn_cvt_pk_f32_fp8((int)w.x, false), b = __builtin_amdgcn_cvt_pk_f32_fp8((int)w.x, true); lo.x = cvt_pk_bf16(a[0], a[1]); lo.y = cvt_pk_bf16(b[0], b[1]); }
                { f32x2 a = __builtin_amdgcn_cvt_pk_f32_fp8((int)w.y, false), b = __builtin_amdgcn_cvt_pk_f32_fp8((int)w.y, true); lo.z = cvt_pk_bf16(a[0], a[1]); lo.w = cvt_pk_bf16(b[0], b[1]); }
                { f32x2 a = __builtin_amdgcn_cvt_pk_f32_fp8((int)w.z, false), b = __builtin_amdgcn_cvt_pk_f32_fp8((int)w.z, true); hi.x = cvt_pk_bf16(a[0], a[1]); hi.y = cvt_pk_bf16(b[0], b[1]); }
                { f32x2 a = __builtin_amdgcn_cvt_pk_f32_fp8((int)w.w, false), b = __builtin_amdgcn_cvt_pk_f32_fp8((int)w.w, true); hi.z = cvt_pk_bf16(a[0], a[1]); hi.w = cvt_pk_bf16(b[0], b[1]); }
                LAS unsigned char* img = kvsel ? Vimg : Kimg;
                *(LAS u32x4*)(img + o0) = lo; *(LAS u32x4*)(img + o1) = hi; } }
#pragma unroll
        for (int q = 0; q < 2; ++q) { const int e = tid + 512 * q, sc = e / ABIAS_STR, k = e - sc * ABIAS_STR, sub = 160 - (k + sc);
            if (e < 4 * ABIAS_STR) biasC[e] = (sub >= 0 && sub <= 128) ? bval[q] * 1.4426950408889634f : -INFINITY; }
        Qf8 = __builtin_shufflevector(__builtin_bit_cast(pg8::i32x4, Qn[0]), __builtin_bit_cast(pg8::i32x4, Qn[1]), 0, 1, 2, 3, 4, 5, 6, 7);
        const AttnU Uc = U;
        __syncthreads();
        int flip_next = flip;
        if (unit + 1 < u1) { U = attn_decode(unit + 1);
            const bool reuse = U.b == Uc.b && U.g == Uc.g && U.h == Uc.h && U.c == Uc.c && U.n == Uc.n + 1;
            need_prev = U.n > 0 && !reuse; flip_next = reuse ? flip ^ 1 : flip;
            attn_issue(P, rel_bias, U, need_prev, tid, wave, lane, kv, vv, Qn, bval); }
        const int n = Uc.n;
        const int qrow = 16 * wave + qi;
        const size_t qtok = (size_t)((n * 128 + qrow) * Uc.r + Uc.c);
        const int kt0 = 2 * (wave >> 1);
        const int kperm = 8 * ((qi >> 2) & 1) + 4 * (qi >> 3) + (qi & 3), gperm = 8 * (gq & 1) + 4 * (gq >> 1);
        const int nskip = (n == 0) ? 8 - kt0 : 0;
        f32x4 S[10];
#pragma unroll
        for (int i = 0; i < 10; ++i) { S[i] = (f32x4){0.f, 0.f, 0.f, 0.f};
            if (i < nskip) continue;
            const LAS unsigned char* Kt = Kimg + (kt0 + i < 8 ? (flip_c << 14) : -(flip_c << 14));
            const int krow = 16 * (kt0 + i) + kperm;
            const pg8::i32x8 k8 = __builtin_shufflevector(*(const LAS pg8::i32x4*)(Kt + kimg8(krow, 2 * gq)), *(const LAS pg8::i32x4*)(Kt + kimg8(krow, 2 * gq + 1)), 0, 1, 2, 3, 4, 5, 6, 7);
            asm("s_nop 1\n\tv_mfma_f32_16x16x128_f8f6f4 %0, %1, %2, %0" : "+v"(S[i]) : "v"(k8), "v"(Qf8)); }
        asm volatile("s_nop 15\n\ts_nop 15" ::: "memory");
        const int sl = (-qi) & 3;
        const LAS float* brow = biasC + sl * ABIAS_STR + (16 * kt0 + gperm - qrow + 32 - sl);
        const LAS float* bninf = biasC + sl * ABIAS_STR + ABIAS_NINF;
        float mx = -INFINITY;
#pragma unroll
        for (int i = 0; i < 10; ++i) { const f32x4 bb = *(const LAS f32x4*)(i < nskip ? bninf : brow + 16 * i);
#pragma unroll
            for (int j = 0; j < 4; ++j) { S[i][j] = __builtin_fmaf(S[i][j], 0.08838834764831845f * 1.4426950408889634f / (pg8::V8_MUL * pg8::V8_MUL), bb[j]); mx = fmaxf(mx, S[i][j]); } }
        mx = rows_max(mx);
        float sum = 0.f;
#pragma unroll
        for (int i = 0; i < 10; ++i)
#pragma unroll
            for (int j = 0; j < 4; ++j) { const float p = __builtin_amdgcn_exp2f(S[i][j] - mx); S[i][j] = p; sum += p; }
        sum = rows_sum(sum);
        f32x4 O[8];
#pragma unroll
        for (int cc = 0; cc < 8; ++cc) O[cc] = (f32x4){0.f, 0.f, 0.f, 0.f};
#pragma unroll
        for (int ks = 0; ks < 5; ++ks) {
            if (2 * ks + 1 < nskip) continue;
            const LAS unsigned char* Vt = Vimg + (kt0 + 2 * ks < 8 ? fx : -fx);
            u32x4 pw; pw.x = cvt_pk_bf16(S[2 * ks][0], S[2 * ks][1]); pw.y = cvt_pk_bf16(S[2 * ks][2], S[2 * ks][3]);
            pw.z = cvt_pk_bf16(S[2 * ks + 1][0], S[2 * ks + 1][1]); pw.w = cvt_pk_bf16(S[2 * ks + 1][2], S[2 * ks + 1][3]);
            const bf16x8 pb = __builtin_bit_cast(bf16x8, pw);
            const int rbase = 16 * kt0 + 32 * ks + gperm + q4;
#pragma unroll
            for (int cc = 0; cc < 8; ++cc) {
                const s16x4 v0 = __builtin_amdgcn_ds_read_tr16_b64_v4i16((LAS s16x4*)(Vt + off_b(rbase, 2 * cc + (p4 >> 1)) + 8 * (p4 & 1)));
                const s16x4 v1 = __builtin_amdgcn_ds_read_tr16_b64_v4i16((LAS s16x4*)(Vt + off_b(rbase + 16, 2 * cc + (p4 >> 1)) + 8 * (p4 & 1)));
                bf16x8 vf; vf[0] = v0[0]; vf[1] = v0[1]; vf[2] = v0[2]; vf[3] = v0[3]; vf[4] = v1[0]; vf[5] = v1[1]; vf[6] = v1[2]; vf[7] = v1[3];
                O[cc] = __builtin_amdgcn_mfma_f32_16x16x32_bf16(vf, pb, O[cc], 0, 0, 0); }
        }
        const float inv = __builtin_amdgcn_rcpf(sum);
        const size_t tok = (size_t)Uc.b * SEQ + qtok;
        unsigned char* orow = (unsigned char*)og + ((size_t)Uc.g * T + tok) * BW + Uc.h * 128 + 4 * gq;
        const float inv16 = inv * (pg8::YA_MUL / pg8::V8_MUL);
        {
            unsigned o8[8];
#pragma unroll
            for (int cc = 0; cc < 8; ++cc) o8[cc] = pk4_fp8(O[cc][0] * inv16, O[cc][1] * inv16, O[cc][2] * inv16, O[cc][3] * inv16);
            unsigned char* obase = orow - 4 * gq;
#pragma unroll
            for (int c4 = 0; c4 < 2; ++c4) { unsigned r0 = o8[4 * c4], r1 = o8[4 * c4 + 1], r2 = o8[4 * c4 + 2], r3 = o8[4 * c4 + 3];
                { auto a = __builtin_amdgcn_permlane16_swap(r0, r1, false, false); r0 = a[0]; r1 = a[1]; auto b = __builtin_amdgcn_permlane16_swap(r2, r3, false, false); r2 = b[0]; r3 = b[1]; }
                { auto a = __builtin_amdgcn_permlane32_swap(r0, r2, false, false); r0 = a[0]; r2 = a[1]; auto b = __builtin_amdgcn_permlane32_swap(r1, r3, false, false); r1 = b[0]; r3 = b[1]; }
                u32x4 ov; ov.x = r0; ov.y = r1; ov.z = r2; ov.w = r3;
                *(u32x4*)(obase + 16 * (4 * c4 + gq)) = ov; } }
        if (gq == 0) lse[((size_t)Uc.g * T + tok) * 8 + Uc.h] = (mx + __builtin_amdgcn_logf(sum)) * 0.6931471805599453f;
        __syncthreads();
        flip = flip_next;
    }
}

__device__ __forceinline__ void sgu_load_group(const Args& a, const bf16_t* P, size_t t0, int gg, int tid, f32x4 (&wreg)[4][2], u32x4 (&vreg)[4]) {
    const float* sw = a.in[I_SW];
#pragma unroll
    for (int k = 0; k < 4; ++k) { const int id = tid + 512 * k, i = id >> 4, ch = id & 15;
        const float* wp = sw + ((size_t)gg * 128 + i) * 128 + ch * 8; wreg[k][0] = *(const f32x4*)wp; wreg[k][1] = *(const f32x4*)(wp + 4);
        vreg[k] = *(const u32x4*)(P + (t0 + i) * INC + O_Z + BW + gg * 128 + ch * 8); }
}
__device__ __forceinline__ void sgu_unit(LAS unsigned char* lds, const Args& a, const bf16_t* P, bf16_t* ys, int unit, int tid, int wave, int lane) {
    const int gh = unit & 1, bc = unit >> 1;
    const size_t t0 = (size_t)bc * 128;
    LAS unsigned char* Wimg = lds; LAS unsigned char* Vimg = lds + 32768; LAS float* mu = (LAS float*)(lds + 65536); LAS float* rs = mu + 128;
    LAS float* lgl = (LAS float*)(lds + 65536 + 1024); LAS float* lbl = lgl + 1024;
    const float* sb = a.in[I_SB];
    f32x4 wreg[4][2]; u32x4 vreg[4];
    sgu_load_group(a, P, t0, gh * 4, tid, wreg, vreg);
    for (int i = tid; i < BW; i += NTHR) { lgl[i] = a.in[I_SLNG][i]; lbl[i] = a.in[I_SLNB][i]; }
    {
        const int row = tid >> 2, part = tid & 3; const bf16_t* src = P + (t0 + row) * INC + O_Z + BW + part * 8;
        float s = 0.f, q = 0.f;
#pragma unroll 8
        for (int i = 0; i < 32; ++i) { const u32x4 w = *(const u32x4*)(src + i * 32);
            const float v0 = bf_lo(w.x), v1 = bf_hi(w.x), v2 = bf_lo(w.y), v3 = bf_hi(w.y), v4 = bf_lo(w.z), v5 = bf_hi(w.z), v6 = bf_lo(w.w), v7 = bf_hi(w.w);
            s += ((v0 + v1) + (v2 + v3)) + ((v4 + v5) + (v6 + v7)); q += ((v0 * v0 + v1 * v1) + (v2 * v2 + v3 * v3)) + ((v4 * v4 + v5 * v5) + (v6 * v6 + v7 * v7)); }
        s += dppf<0xB1>(s); s += dppf<0x4E>(s); q += dppf<0xB1>(q); q += dppf<0x4E>(q);
        const float mean = s * (1.0f / 1024.0f); const float var = fmaxf(q * (1.0f / 1024.0f) - mean * mean, 0.f);
        if (part == 0) { mu[row] = mean; rs[row] = 1.0f / sqrtf(var + LN_EPS); } }
    __syncthreads();
    const int li = lane & 15, gq = lane >> 4, q4 = li >> 2, p4 = li & 3;
    for (int gi = 0; gi < 4; ++gi) { const int gg = gh * 4 + gi;
#pragma unroll
        for (int k = 0; k < 4; ++k) { const int id = tid + 512 * k, i = id >> 4, ch = id & 15;
            float w[8] = {wreg[k][0][0], wreg[k][0][1], wreg[k][0][2], wreg[k][0][3], wreg[k][1][0], wreg[k][1][1], wreg[k][1][2], wreg[k][1][3]};
#pragma unroll
            for (int j = 0; j < 8; ++j) if (ch * 8 + j > i) w[j] = 0.f;
            u32x4 o; o.x = cvt_pk_bf16(w[0], w[1]); o.y = cvt_pk_bf16(w[2], w[3]); o.z = cvt_pk_bf16(w[4], w[5]); o.w = cvt_pk_bf16(w[6], w[7]);
            *(LAS u32x4*)(Wimg + off_b(i, ch)) = o;
            const int chn = gg * 128 + ch * 8; const u32x4 vw = vreg[k];
            const f32x4 g0 = *(const LAS f32x4*)(lgl + chn), g1 = *(const LAS f32x4*)(lgl + chn + 4), b0 = *(const LAS f32x4*)(lbl + chn), b1 = *(const LAS f32x4*)(lbl + chn + 4);
            const float m_ = mu[i], r_ = rs[i];
            float v[8] = {bf_lo(vw.x), bf_hi(vw.x), bf_lo(vw.y), bf_hi(vw.y), bf_lo(vw.z), bf_hi(vw.z), bf_lo(vw.w), bf_hi(vw.w)};
            v[0] = (v[0] - m_) * r_ * g0[0] + b0[0]; v[1] = (v[1] - m_) * r_ * g0[1] + b0[1]; v[2] = (v[2] - m_) * r_ * g0[2] + b0[2]; v[3] = (v[3] - m_) * r_ * g0[3] + b0[3];
            v[4] = (v[4] - m_) * r_ * g1[0] + b1[0]; v[5] = (v[5] - m_) * r_ * g1[1] + b1[1]; v[6] = (v[6] - m_) * r_ * g1[2] + b1[2]; v[7] = (v[7] - m_) * r_ * g1[3] + b1[3];
            u32x4 ov; ov.x = cvt_pk_bf16(v[0], v[1]); ov.y = cvt_pk_bf16(v[2], v[3]); ov.z = cvt_pk_bf16(v[4], v[5]); ov.w = cvt_pk_bf16(v[6], v[7]);
            *(LAS u32x4*)(Vimg + off_b(i, ch)) = ov; }
        __syncthreads();
        if (gi < 3) sgu_load_group(a, P, t0, gg + 1, tid, wreg, vreg);
        const int itok = 16 * wave + li; const float bs = sb[gg * 128 + itok];
        const bf16_t* up = P + (t0 + itok) * INC + O_Z + gg * 128 + 4 * gq;
        u32x2 uu[8];
#pragma unroll
        for (int cc = 0; cc < 8; ++cc) uu[cc] = *(const u32x2*)(up + 16 * cc);
        bf16x8 Af[4];
#pragma unroll
        for (int s = 0; s < 4; ++s) Af[s] = *(const LAS bf16x8*)(Wimg + off_b(16 * wave + li, 4 * s + gq));
        bf16_t* yp = ys + (t0 + itok) * BW + gg * 128 + 4 * gq; unsigned y8[8];
#pragma unroll
        for (int cc = 0; cc < 8; ++cc) { f32x4 C = (f32x4){0.f, 0.f, 0.f, 0.f};
#pragma unroll
            for (int s = 0; s < 4; ++s) { const int rbase = 32 * s + 8 * gq + q4;
                const s16x4 v0 = __builtin_amdgcn_ds_read_tr16_b64_v4i16((LAS s16x4*)(Vimg + off_b(rbase, 2 * cc + (p4 >> 1)) + 8 * (p4 & 1)));
                const s16x4 v1 = __builtin_amdgcn_ds_read_tr16_b64_v4i16((LAS s16x4*)(Vimg + off_b(rbase + 4, 2 * cc + (p4 >> 1)) + 8 * (p4 & 1)));
                bf16x8 vf; vf[0] = v0[0]; vf[1] = v0[1]; vf[2] = v0[2]; vf[3] = v0[3]; vf[4] = v1[0]; vf[5] = v1[1]; vf[6] = v1[2]; vf[7] = v1[3];
                C = __builtin_amdgcn_mfma_f32_16x16x32_bf16(vf, Af[s], C, 0, 0, 0); }
#if P4B_FP8
            y8[cc] = pg8::pk4_fp8(bf_lo(uu[cc].x) * (C[0] + bs) * pg8::YS_MUL, bf_hi(uu[cc].x) * (C[1] + bs) * pg8::YS_MUL, bf_lo(uu[cc].y) * (C[2] + bs) * pg8::YS_MUL, bf_hi(uu[cc].y) * (C[3] + bs) * pg8::YS_MUL);
            if ((cc & 3) == 3) { unsigned r0 = y8[cc - 3], r1_ = y8[cc - 2], r2 = y8[cc - 1], r3 = y8[cc];
                { auto p_ = __builtin_amdgcn_permlane16_swap(r0, r1_, false, false); r0 = p_[0]; r1_ = p_[1]; auto q_ = __builtin_amdgcn_permlane16_swap(r2, r3, false, false); r2 = q_[0]; r3 = q_[1]; }
                { auto p_ = __builtin_amdgcn_permlane32_swap(r0, r2, false, false); r0 = p_[0]; r2 = p_[1]; auto q_ = __builtin_amdgcn_permlane32_swap(r1_, r3, false, false); r1_ = q_[0]; r3 = q_[1]; }
                u32x4 ov; ov.x = r0; ov.y = r1_; ov.z = r2; ov.w = r3;
                *(u32x4*)((unsigned char*)ys + (t0 + itok) * BW + gg * 128 + 16 * (cc - 3 + gq)) = ov; } }
#else
            u32x2 o; o.x = cvt_pk_bf16(bf_lo(uu[cc].x) * (C[0] + bs), bf_hi(uu[cc].x) * (C[1] + bs)); o.y = cvt_pk_bf16(bf_lo(uu[cc].y) * (C[2] + bs), bf_hi(uu[cc].y) * (C[3] + bs));
            *(u32x2*)(yp + 16 * cc) = o; }
#endif
        __syncthreads();
    }
}

typedef float f32x16 __attribute__((ext_vector_type(16)));
__device__ __forceinline__ void p6_ln1_router(LAS unsigned char* lds, const Args& a, int grp, int tid, int wave, int lane) {
    unsigned char* ws = a.ws;
    const float* r1 = (const float*)(ws + WS_R1); bf16_t* hb = (bf16_t*)(ws + WS_HB); unsigned char* hq = ws + WS_H;
    LAS float* red = (LAS float*)lds;
    LAS float* logit = (LAS float*)(lds + 65536);
    LAS float* stat = (LAS float*)(lds + 73728);
    LAS float* cgb = (LAS float*)(lds + 74752);
    LAS float* pred = (LAS float*)(lds + 75264);
    LAS int* sel_e = (LAS int*)(lds + 79360);
    LAS float* sel_g = (LAS float*)(lds + 80384);
    LAS int* lrank = (LAS int*)(lds + 81408);
    LAS int* hist = (LAS int*)(lds + 82432);
    LAS int* base = (LAS int*)(lds + 82560);
    const float* Wr = a.in[I_WR]; const float* g1 = a.in[I_LN1G]; const float* b1 = a.in[I_LN1B];
    if (tid < 32) hist[tid] = 0;
    if (tid < 64) cgb[tid] = ((const float*)(ws + WS_CGB))[tid];
    for (int ti = 0; ti < 8; ti += 2) {
        const int tl = wave * 8 + ti; const size_t t = (size_t)grp * 64 + tl;
        f32x4 xv[2][8]; float s[2] = {0.f, 0.f};
#pragma unroll
        for (int r = 0; r < 2; ++r)
#pragma unroll
            for (int i = 0; i < 8; ++i) { const u32x2 rw = *(const u32x2*)((const bf16_t*)r1 + (t + r) * DM + 4 * lane + 256 * i); xv[r][i] = (f32x4){bf_lo(rw.x), bf_hi(rw.x), bf_lo(rw.y), bf_hi(rw.y)};
                s[r] += (xv[r][i][0] + xv[r][i][1]) + (xv[r][i][2] + xv[r][i][3]); }
#pragma unroll
        for (int r = 0; r < 2; ++r) {
            const float mean = wave_sum(s[r]) * (1.0f / DM); float q = 0.f;
#pragma unroll
            for (int i = 0; i < 8; ++i) { xv[r][i] = xv[r][i] - mean; q += (xv[r][i][0] * xv[r][i][0] + xv[r][i][1] * xv[r][i][1]) + (xv[r][i][2] * xv[r][i][2] + xv[r][i][3] * xv[r][i][3]); }
            const float rstd = 1.0f / sqrtf(wave_sum(q) * (1.0f / DM) + LN_EPS);
#pragma unroll
            for (int i = 0; i < 8; ++i) { const int k = 4 * lane + 256 * i; const f32x4 gv = *(const f32x4*)(g1 + k), bv = *(const f32x4*)(b1 + k);
                const f32x4 hv = xv[r][i] * rstd * gv + bv;
                *(unsigned*)(hq + (t + r) * DM + k) = pk4_fp8(hv[0], hv[1], hv[2], hv[3]); }
            if (lane == 0) { stat[(tl + r) * 2] = mean; stat[(tl + r) * 2 + 1] = rstd; f32x2 st; st[0] = mean; st[1] = rstd; *(f32x2*)((float*)hb + (t + r) * 2) = st; }
        }
    }
    {
        f32x16 C0, C1;
#pragma unroll
        for (int i = 0; i < 16; ++i) { C0[i] = 0.f; C1[i] = 0.f; }
        const int i = lane & 31, kh = lane >> 5;
        const bf16_t* ra0 = (const bf16_t*)r1 + ((size_t)grp * 64 + i) * DM + wave * 256 + 8 * kh; const bf16_t* ra1 = ra0 + (size_t)32 * DM;
        const bf16_t* wg = (const bf16_t*)(ws + WS_WG3) + (size_t)i * DM + wave * 256 + 8 * kh;
#pragma unroll 4
        for (int st = 0; st < 16; ++st) { const bf16x8 a0 = *(const bf16x8*)(ra0 + 16 * st), a1 = *(const bf16x8*)(ra1 + 16 * st);
#pragma unroll
            for (int pt = 0; pt < 3; ++pt) { const bf16x8 bw = *(const bf16x8*)(wg + (size_t)pt * NE * DM + 16 * st);
                C0 = __builtin_amdgcn_mfma_f32_32x32x16_bf16(a0, bw, C0, 0, 0, 0); C1 = __builtin_amdgcn_mfma_f32_32x32x16_bf16(a1, bw, C1, 0, 0, 0); } }
#pragma unroll
        for (int rg = 0; rg < 16; ++rg) { const int row = (rg & 3) + 8 * (rg >> 2) + 4 * kh; red[(wave * 64 + row) * 32 + i] = C0[rg]; red[(wave * 64 + 32 + row) * 32 + i] = C1[rg]; }
    }
    __syncthreads();
#pragma unroll
    for (int r = 0; r < 4; ++r) { const int idx = tid + 512 * r, tok = idx >> 5, e = idx & 31; float s = 0.f;
#pragma unroll
        for (int w = 0; w < 8; ++w) s += red[(w * 64 + tok) * 32 + e];
        logit[tok * 32 + (e ^ (tok & 31))] = stat[tok * 2 + 1] * (s - stat[tok * 2] * cgb[e]) + cgb[32 + e]; }
    __syncthreads();
    if (tid < 64) {
        float v[32];
#pragma unroll
        for (int e = 0; e < 32; ++e) v[e] = logit[tid * 32 + (e ^ (tid & 31))];
        unsigned taken = 0u; int se[4]; float sv[4];
#pragma unroll
        for (int rr = 0; rr < 4; ++rr) { float m = -INFINITY; int idx = 0;
#pragma unroll
            for (int e = 0; e < 32; ++e) { const bool ok = ((taken >> e) & 1u) == 0u && v[e] > m; m = ok ? v[e] : m; idx = ok ? e : idx; }
            se[rr] = idx; sv[rr] = m; taken |= 1u << idx; }
        const float e1 = __expf(sv[1] - sv[0]), e2 = __expf(sv[2] - sv[0]), e3 = __expf(sv[3] - sv[0]); const float inv = 1.0f / (1.0f + e1 + e2 + e3);
        const float gt[4] = {inv, e1 * inv, e2 * inv, e3 * inv};
#pragma unroll
        for (int rr = 0; rr < 4; ++rr) { const int slot = tid * 4 + rr; sel_e[slot] = se[rr]; sel_g[slot] = gt[rr]; lrank[slot] = atomicAdd((int*)(hist + se[rr]), 1); }
    }
    __syncthreads();
    unsigned* cntw = (unsigned*)(ws + WS_CTL) + CW_CNT;
    if (tid < 32) base[tid] = (int)__hip_atomic_fetch_add(cntw + 64 * tid, (unsigned)hist[tid], RLX_AGENT);
    __syncthreads();
    if (tid < 256) { const int ee = sel_e[tid], rank = base[ee] + lrank[tid]; const int t = grp * 64 + (tid >> 2);
        ((int*)(ws + WS_TOKE))[t * 4 + (tid & 3)] = ee; ((int*)(ws + WS_TOKR))[t * 4 + (tid & 3)] = rank;
        ((int*)(ws + WS_SLOTTOK))[(size_t)ee * T + rank] = t; ((float*)(ws + WS_SLOTGATE))[(size_t)ee * T + rank] = sel_g[tid]; }
    __syncthreads();
}

__device__ __forceinline__ void load_expert_tables(LAS unsigned char* lds, unsigned char* ws, int tid) {
    LAS int* cnt = (LAS int*)(lds + SMALL_OFF); LAS int* tpre = (LAS int*)(lds + SMALL_OFF + 256);
    unsigned* cntw = (unsigned*)(ws + WS_CTL) + CW_CNT;
    if (tid < 32) cnt[tid] = (int)__hip_atomic_load(cntw + 64 * tid, RLX_AGENT);
    __syncthreads();
    if (tid < 64) {
        const int tiles = tid < NE ? (cnt[tid] + 255) >> 8 : 0; int inc = tiles;
#pragma unroll
        for (int o = 1; o < 32; o <<= 1) { const int v = __shfl_up(inc, o); if ((tid & 63) >= o) inc += v; }
        if (tid < NE) tpre[tid] = inc - tiles;
        if (tid == NE - 1) tpre[NE] = inc; }
    __syncthreads();
}

constexpr int NPH = 10;
__global__ void __launch_bounds__(NTHR, 2) fwd_kernel(Args args) {
    extern __shared__ __attribute__((aligned(16))) unsigned char lds_raw[];
    LAS unsigned char* lds = (LAS unsigned char*)lds_raw;
    const int tid = threadIdx.x, lane = tid & 63, wave = __builtin_amdgcn_readfirstlane(tid >> 6);
    const int G = gridDim.x, bx = blockIdx.x; const int vcu = (G % 8 == 0) ? (bx % 8) * (G / 8) + bx / 8 : bx;
    unsigned char* ws = args.ws;
    volatile LAS unsigned* MISC = (volatile LAS unsigned*)(lds + MISC_OFF);
    if (tid < 64) MISC[tid] = 0u;
    __syncthreads();
    XcdBarrier bar; bar.bar = (unsigned*)(ws + WS_CTL) + CW_BAR; bar.x = 0; bar.st = nullptr;
    if (MK_N_LAUNCHES == 1) bar = xcd_barrier_post((unsigned*)(ws + WS_CTL) + CW_BAR, MISC + 8);
    const int lo = args.ph_lo, hi = args.ph_hi;
#ifndef PHASE_MASK
#define PHASE_MASK 0x3ff
#endif
#define IN(k) (((PHASE_MASK >> (k)) & 1) && lo <= (k) && (k) < hi)
#define BOTH(k) (IN(k) && IN((k) + 1))
#define GRID_BAR(k) do { if (BOTH(k)) xcd_barrier(bar); } while (0)
    bf16_t* Pbuf = (bf16_t*)(ws + WS_P);

    if (IN(0)) { p0_prologue(args, lds, vcu, G, wave, lane); __syncthreads(); if (PROBE_DBL == 0) { p0_prologue(args, lds, vcu, G, wave, lane); __syncthreads(); } GRID_BAR(0); }

    if (IN(1)) REPS(1) {
#if P1_I8
        const int sg = (bx >> 3) & 15;
        pg8::DenseI8 S; S.init((const bf16_t*)(ws + WS_XB), (const bf16_t*)(ws + WS_WIN), T, INC, DM / 2, G, bx); S.rep = DBL(1); S.ranged = 1;
        pg8::EpiProjT<true> E{Pbuf, (bf16_t*)(ws + WS_QKV), 1.0f, (const float*)(ws + WS_XS), (const float*)(ws + WS_WCS)};
        typedef pg8::DenseI8 P1Prob; typedef pg8::EpiProjT<true> P1Epi;
#elif P1_FP8
        {
            pg8::Dense Sz; Sz.init((const bf16_t*)(ws + WS_H + 64 * MiB), (const bf16_t*)(ws + WS_WIN + 32 * MiB), T, BW, DM, G, bx); Sz.pn_off = 36; Sz.rep = DBL(1);
            pg8::EpiProj Ez{Pbuf, (bf16_t*)(ws + WS_QKV), 1.0f, nullptr, nullptr};
            pg8::gemm_phase<pg8::EpiProj, pg8::Dense>(lds, Sz, Ez);
        }
        const int sg = (bx >> 3) % 15;
        pg8::Dense8 S; S.init((const bf16_t*)(ws + WS_XB), (const bf16_t*)(ws + WS_WIN), T, INC - BW, DM / 2, G, bx); S.gap_lo = 36; S.gap_n = 4; S.rep = DBL(1);
        pg8::EpiProj E{Pbuf, (bf16_t*)(ws + WS_QKV), pg8::W8_INV, nullptr, nullptr};
        typedef pg8::Dense8 P1Prob; typedef pg8::EpiProj P1Epi;
#else
        const int sg = (bx >> 3) & 15;
        pg8::Dense S; S.init((const bf16_t*)(ws + WS_XB), (const bf16_t*)(ws + WS_WIN), T, INC, DM, G, bx);
        pg8::EpiProj E{Pbuf, (bf16_t*)(ws + WS_QKV), 1.0f, nullptr, nullptr};
        typedef pg8::Dense P1Prob; typedef pg8::EpiProj P1Epi;
#endif
        S.i0 = 0; S.i1 = sg;
        pg8::gemm_phase<P1Epi, P1Prob>(lds, S, E);
        cvt8s_run<DM, 2 * EH, 2 * EH, 1>(args.in[I_WGU], ws + WS_WGU, NE * (DM / 128) * (2 * EH / 256), bx, G, tid, wave, lds, DBL(11));
        {
            const int gw = bx * NWAVES + wave, NGW = G * NWAVES; LAS unsigned char* scr = lds + wave * 8192;
            cvt8_run<BW, DM, DM, 0>(args.in[I_WBR], ws + WS_WBR, (BW / 128) * (DM / 32), gw, NGW, lane, scr);
#if P4B_FP8
            cvt8_run<BW, DM, DM, 0>(args.in[I_WBR] + (size_t)BW * DM, ws + WS_WBR + 4 * MiB, (BW / 128) * (DM / 32), gw, NGW, lane, scr);
#else
            { CvtJob j{args.in[I_WBR] + (size_t)BW * DM, (bf16_t*)(ws + WS_WBR) + (size_t)DM * BW, BW, DM, 0, 0}; cvt_run(j, (BW / 64) * (DM / 64), gw, NGW, lane, scr); }
#endif
#if P5_FP8
            cvt8_run<DM, DM, DM, 0>(args.in[I_WOUT], ws + WS_WOUT, (DM / 128) * (DM / 32), gw, NGW, lane, scr);
#else
            { CvtJob j{args.in[I_WOUT], (bf16_t*)(ws + WS_WOUT), DM, DM, 0, 0}; cvt_run(j, (DM / 64) * (DM / 64), gw, NGW, lane, scr); }
#endif
        }
        __syncthreads();
        S.i0 = sg; S.i1 = 1 << 28;
        pg8::gemm_phase<P1Epi, P1Prob>(lds, S, E);
        GRID_BAR(1);
    }

    if (IN(2)) REPS(2) {
        for (int u = vcu; u < 256 * DBL(12); u += G) sgu_unit(lds, args, Pbuf, (bf16_t*)(ws + WS_YS), u & 255, tid, wave, lane);
        attn_phase(lds, (const bf16_t*)(ws + WS_QKV), (bf16_t*)(ws + WS_OG), (float*)(ws + WS_LSE), args.in[I_RELB], vcu, G, DBL(2) * 3072, tid, wave, lane);
#if PROBE_PHASE == 12
        for (int u = vcu; u < 256; u += G) sgu_unit(lds, args, Pbuf, (bf16_t*)(ws + WS_YS), u, tid, wave, lane);
        for (int u = vcu; u < 256; u += G) sgu_unit(lds, args, Pbuf, (bf16_t*)(ws + WS_YS), u, tid, wave, lane);
        for (int u = vcu; u < 256; u += G) sgu_unit(lds, args, Pbuf, (bf16_t*)(ws + WS_YS), u, tid, wave, lane);
#endif
        GRID_BAR(2);
    }

    if (IN(3)) REPS(3) {
        const bf16_t* og = (const bf16_t*)(ws + WS_OG); const float* lse = (const float*)(ws + WS_LSE); bf16_t* ya = (bf16_t*)(ws + WS_YA);
        for (size_t i_ = (size_t)vcu * NTHR + tid; i_ < (size_t)T * 64 * DBL(3); i_ += (size_t)G * NTHR) { const size_t i = i_ % ((size_t)T * 64);
            const size_t t = i >> 6; const int h = (int)(i & 63) >> 3;
            const float l0 = lse[t * 8 + h], l1 = lse[((size_t)T + t) * 8 + h], l2 = lse[((size_t)2 * T + t) * 8 + h];
            const float m = fmaxf(l0, fmaxf(l1, l2)); const float e0 = __expf(l0 - m), e1 = __expf(l1 - m), e2 = __expf(l2 - m); const float inv = 1.0f / (e0 + e1 + e2);
            const float w0 = e0 * inv, w1 = e1 * inv, w2 = e2 * inv;
            const unsigned char* og8 = (const unsigned char*)og;
            const u32x4 a0 = *(const u32x4*)(og8 + i * 16), a1 = *(const u32x4*)(og8 + ((size_t)T * 64 + i) * 16), a2 = *(const u32x4*)(og8 + ((size_t)2 * T * 64 + i) * 16);
            u32x4 o;
#pragma unroll
            for (int c = 0; c < 4; ++c) {
                const f32x2 rlo = __builtin_amdgcn_cvt_pk_f32_fp8((int)a0[c], false) * w0 + __builtin_amdgcn_cvt_pk_f32_fp8((int)a1[c], false) * w1 + __builtin_amdgcn_cvt_pk_f32_fp8((int)a2[c], false) * w2;
                const f32x2 rhi = __builtin_amdgcn_cvt_pk_f32_fp8((int)a0[c], true) * w0 + __builtin_amdgcn_cvt_pk_f32_fp8((int)a1[c], true) * w1 + __builtin_amdgcn_cvt_pk_f32_fp8((int)a2[c], true) * w2;
                o[c] = pk4_fp8(rlo[0], rlo[1], rhi[0], rhi[1]); }
            *(u32x4*)((unsigned char*)ya + i * 16) = o;
        }
        GRID_BAR(3);
    }

    if (IN(4)) REPS(4) {
        { pg8::Dense8 S; S.init((const bf16_t*)(ws + WS_YA), (const bf16_t*)(ws + WS_WBR), T, DM, BW / 2, G, bx); S.rep = DBL(4);
          pg8::EpiBranch<0> E{Pbuf, (bf16_t*)(ws + WS_T0), (bf16_t*)(ws + WS_MP), pg8::W8_INV / pg8::YA_MUL};
          pg8::gemm_phase<pg8::EpiBranch<0>, pg8::Dense8>(lds, S, E); }
#if P4B_FP8
        { pg8::Dense8 S; S.init((const bf16_t*)(ws + WS_YS), (const bf16_t*)(ws + WS_WBR + 4 * MiB), T, DM, BW / 2, G, bx); S.rep = DBL(4);
          pg8::EpiBranch<1> E{Pbuf, (bf16_t*)(ws + WS_T0), (bf16_t*)(ws + WS_MP), pg8::W8_INV / pg8::YS_MUL};
          pg8::gemm_phase<pg8::EpiBranch<1>, pg8::Dense8>(lds, S, E); }
#else
        { pg8::Dense S; S.init((const bf16_t*)(ws + WS_YS), (const bf16_t*)(ws + WS_WBR) + (size_t)DM * BW, T, DM, BW, G, bx); S.rep = DBL(4);
          pg8::EpiBranch<1> E{Pbuf, (bf16_t*)(ws + WS_T0), (bf16_t*)(ws + WS_MP), 1.0f};
          pg8::gemm_phase<pg8::EpiBranch<1>, pg8::Dense>(lds, S, E); }
#endif
        GRID_BAR(4);
    }

    if (IN(5)) REPS(5) {
#if P5_FP8
        pg8::Dense8 S; S.init((const bf16_t*)(ws + WS_MP), (const bf16_t*)(ws + WS_WOUT), T, DM, DM / 2, G, bx); S.rep = DBL(5);
        pg8::EpiOut E{args.in[I_X], (float*)(ws + WS_R1), pg8::W8_INV / pg8::MP_MUL};
        pg8::gemm_phase<pg8::EpiOut, pg8::Dense8>(lds, S, E);
#else
        pg8::Dense S; S.init((const bf16_t*)(ws + WS_MP), (const bf16_t*)(ws + WS_WOUT), T, DM, DM, G, bx); S.rep = DBL(5);
        pg8::EpiOut E{args.in[I_X], (float*)(ws + WS_R1), 1.0f};
        pg8::gemm_phase<pg8::EpiOut, pg8::Dense>(lds, S, E);
#endif
#if PROBE_PHASE == 5
        pg8::gemm_phase<pg8::EpiOut, pg8::Dense>(lds, S, E);
#endif

        GRID_BAR(5);
    }

    if (IN(6)) {
        for (int grp = bx; grp < T / 64; grp += G) p6_ln1_router(lds, args, grp, tid, wave, lane);
        GRID_BAR(6);
    }

    if (IN(7)) REPS(7) {
        load_expert_tables(lds, ws, tid);
        LAS int* cnt = (LAS int*)(lds + SMALL_OFF); LAS int* tpre = (LAS int*)(lds + SMALL_OFF + 256); LAS int* toktab = (LAS int*)(lds + TOKTAB_OFF);
        pg8::Moe<true, true> S; S.A = (const bf16_t*)(ws + WS_H); S.Bt = (const bf16_t*)(ws + WS_WGU); S.K = DM / 2; S.nN = 16; S.G = G; S.c = bx; S.tpre = tpre; S.toktab = toktab; S.cnt = cnt; S.utab = (LAS int*)(lds + SMALL_OFF + 512); S.i0 = 0; S.i1 = 1 << 28; S.rep = 1;
        S.fill_units(tid);
        {
            const int* slot_tok = (const int*)(ws + WS_SLOTTOK);
            int tv[TOKTAB_UNITS / 2]; const int hsel = tid >> 8, row = tid & 255;
#pragma unroll
            for (int j = 0; j < TOKTAB_UNITS / 2; ++j) { pg8::Unit u; const bool ok = S.next(2 * j + hsel, u); const int rank = ok ? u.pm * 256 + row : 0;
                tv[j] = (ok && rank < cnt[u.e]) ? slot_tok[(size_t)u.e * T + rank] : 0; }
#pragma unroll
            for (int j = 0; j < TOKTAB_UNITS / 2; ++j) toktab[(2 * j + hsel) * 256 + row] = tv[j];
            __syncthreads();
        }
        pg8::EpiGU E{args.in[I_BGU], ws + WS_ACT, tpre};
        const int sg = (bx >> 3) & 15;
        S.i0 = 0; S.i1 = sg;
        pg8::gemm_phase<pg8::EpiGU, pg8::Moe<true, true>>(lds, S, E);
        cvt8s_run<EH, DM, DM, 0>(args.in[I_WDN], ws + WS_WDN, NE * (EH / 128) * (DM / 256), bx, G, tid, wave, lds, DBL(17));
        __syncthreads();
        S.i0 = sg; S.i1 = 1 << 28;
        pg8::gemm_phase<pg8::EpiGU, pg8::Moe<true, true>>(lds, S, E);
        GRID_BAR(7);
    }

    if (IN(8)) REPS(8) {
        load_expert_tables(lds, ws, tid);
        LAS int* cnt = (LAS int*)(lds + SMALL_OFF); LAS int* tpre = (LAS int*)(lds + SMALL_OFF + 256);
        pg8::Moe<false, true> S; S.A = (const bf16_t*)(ws + WS_ACT); S.Bt = (const bf16_t*)(ws + WS_WDN); S.K = EH / 2; S.nN = 8; S.G = G; S.c = bx; S.tpre = tpre; S.toktab = nullptr; S.cnt = cnt; S.utab = (LAS int*)(lds + SMALL_OFF + 512); S.i0 = 0; S.i1 = 1 << 28; S.rep = DBL(8);
        S.fill_units(tid);
        pg8::EpiDown E{args.in[I_BDN], ws + WS_Y, (const float*)(ws + WS_SLOTGATE), tpre, cnt};
        pg8::gemm_phase<pg8::EpiDown, pg8::Moe<false, true>>(lds, S, E);
#if PROBE_PHASE == 8
        pg8::gemm_phase<pg8::EpiDown, pg8::Moe<false, true>>(lds, S, E);
#endif

        GRID_BAR(8);
    }

    if (IN(9)) REPS(9) {
        load_expert_tables(lds, ws, tid);
        LAS int* tpre = (LAS int*)(lds + SMALL_OFF + 256);
        const float* hstat = (const float*)(ws + WS_HB); const bf16_t* r1b = (const bf16_t*)(ws + WS_R1); const float* g1 = args.in[I_LN1G]; const float* b1 = args.in[I_LN1B]; const unsigned char* y = ws + WS_Y;
        const int* toke = (const int*)(ws + WS_TOKE); const int* tokr = (const int*)(ws + WS_TOKR);
        const float* g2 = args.in[I_LN2G]; const float* b2 = args.in[I_LN2B];
        const size_t tbase = (size_t)vcu * NWAVES + wave, tstride = (size_t)G * NWAVES;
        int srow_l = 0;
        { const size_t tt = (tbase + (size_t)(lane >> 2) * tstride) % (size_t)T; if (true) { const int e = toke[tt * 4 + (lane & 3)], rk = tokr[tt * 4 + (lane & 3)]; srow_l = tpre[e] * 256 + rk; } }
        int ti = 0;
        for (size_t t_ = tbase; t_ < (size_t)T * DBL(9); t_ += tstride, ++ti) { const size_t t = t_ % (size_t)T;
            size_t srow[4];
#pragma unroll
            for (int k = 0; k < 4; ++k) srow[k] = (size_t)__shfl(srow_l, (ti & 15) * 4 + k);
            const float mean1 = hstat[t * 2], rstd1 = hstat[t * 2 + 1];
            f32x4 xv[8]; float s = 0.f;
#pragma unroll
            for (int i = 0; i < 8; ++i) { const int k0 = 4 * lane + 256 * i; const u32x2 hw = *(const u32x2*)(r1b + t * DM + k0); const f32x4 gl = *(const f32x4*)(g1 + k0), bl = *(const f32x4*)(b1 + k0);
                f32x4 v = (((f32x4){bf_lo(hw.x), bf_hi(hw.x), bf_lo(hw.y), bf_hi(hw.y)} - mean1) * rstd1 * gl + bl) * ALPHA;
                f32x2 ylo = (f32x2){0.f, 0.f}, yhi = (f32x2){0.f, 0.f};
#pragma unroll
                for (int k = 0; k < 4; ++k) { const int w = *(const int*)(y + srow[k] * DM + k0); ylo += __builtin_amdgcn_cvt_pk_f32_fp8(w, false); yhi += __builtin_amdgcn_cvt_pk_f32_fp8(w, true); }
                v[0] += ylo[0] * (1.0f / pg8::Y_MUL); v[1] += ylo[1] * (1.0f / pg8::Y_MUL); v[2] += yhi[0] * (1.0f / pg8::Y_MUL); v[3] += yhi[1] * (1.0f / pg8::Y_MUL);
                xv[i] = v; s += (v[0] + v[1]) + (v[2] + v[3]); }
            const float mean = wave_sum(s) * (1.0f / DM); float q = 0.f;
#pragma unroll
            for (int i = 0; i < 8; ++i) { xv[i] = xv[i] - mean; q += (xv[i][0] * xv[i][0] + xv[i][1] * xv[i][1]) + (xv[i][2] * xv[i][2] + xv[i][3] * xv[i][3]); }
            const float rstd = 1.0f / sqrtf(wave_sum(q) * (1.0f / DM) + LN_EPS);
#pragma unroll
            for (int i = 0; i < 8; ++i) { const int k0 = 4 * lane + 256 * i; const f32x4 gv = *(const f32x4*)(g2 + k0), bv = *(const f32x4*)(b2 + k0);
                *(f32x4*)(args.out + t * DM + k0) = xv[i] * rstd * gv + bv; }
        }
    }
#undef IN
#undef BOTH
#undef GRID_BAR
}

extern "C" void kernel_launch(void* const* d_in, const int* in_sizes, int n_in, void* d_out, int out_size, void* d_ws, size_t ws_size, hipStream_t stream) {
    static int grid = 0;
    if (grid == 0) {
        if (n_in != 19 || out_size != T * DM || ws_size < WS_END) { fprintf(stderr, "kernel_launch: unexpected shapes (n_in %d out %d ws %zu)\n", n_in, out_size, ws_size); grid = -1; return; }
        int dev = 0, cus = 0, per_cu = 0;
        if (hipGetDevice(&dev) != hipSuccess || hipDeviceGetAttribute(&cus, hipDeviceAttributeMultiprocessorCount, dev) != hipSuccess) { grid = -1; return; }
        if (hipFuncSetAttribute((const void*)fwd_kernel, hipFuncAttributeMaxDynamicSharedMemorySize, LDS_BYTES) != hipSuccess) { fprintf(stderr, "kernel_launch: hipFuncSetAttribute failed\n"); grid = -1; return; }
        if (hipOccupancyMaxActiveBlocksPerMultiprocessor(&per_cu, (const void*)fwd_kernel, NTHR, LDS_BYTES) != hipSuccess || per_cu < 1) { fprintf(stderr, "kernel_launch: occupancy query says %d\n", per_cu); }
        (void)hipGetLastError();
        grid = cus;
    }
    if (grid < 0) return;
    (void)hipMemsetAsync((char*)d_ws + WS_CTL, 0, CTL_ZERO_BYTES, stream);
    Args a{};
    for (int i = 0; i < 19; ++i) a.in[i] = (const float*)d_in[i];
    a.out = (float*)d_out; a.ws = (unsigned char*)d_ws;
#if MK_N_LAUNCHES == 1
    a.ph_lo = 0; a.ph_hi = NPH;
    hipLaunchKernelGGL(fwd_kernel, dim3(grid), dim3(NTHR), LDS_BYTES, stream, a);
#else
    for (int p = 0; p < NPH; ++p) { a.ph_lo = p; a.ph_hi = p + 1; hipLaunchKernelGGL(fwd_kernel, dim3(grid), dim3(NTHR), LDS_BYTES, stream, a); }
#endif
}
```

```cpp
#include <hip/hip_runtime.h>
#include <cstdio>
#include <cstdint>

#ifndef MK_N_LAUNCHES
#define MK_N_LAUNCHES 1
#endif

#ifndef CONV1_WGS
#define CONV1_WGS 1
#endif
#ifndef CONV2_WGS
#define CONV2_WGS 1
#endif
#ifndef P1_FP8
#define P1_FP8 1
#endif
#ifndef P1_Z_BF16
#define P1_Z_BF16 1
#endif
#ifndef P1_I8
#define P1_I8 1
#endif
#ifndef P5_FP8
#define P5_FP8 1
#endif
#ifndef T0_FP8
#define T0_FP8 1
#endif
#ifndef P4B_FP8
#define P4B_FP8 1
#endif
#ifndef PROBE_DBL
#define PROBE_DBL -1
#endif
#define DBL(k) ((PROBE_DBL == (k)) ? 2 : 1)
#ifndef PROBE_PHASE
#define PROBE_PHASE -1
#endif
#ifndef PROBE_N
#define PROBE_N 1
#endif
#define REPS(k)
#define LAS __attribute__((address_space(3)))
#define GAS __attribute__((address_space(1)))
typedef unsigned short bf16_t;
typedef short bf16x8 __attribute__((ext_vector_type(8)));
typedef short s16x4 __attribute__((ext_vector_type(4)));
typedef float f32x4 __attribute__((ext_vector_type(4)));
typedef float f32x2 __attribute__((ext_vector_type(2)));
typedef unsigned u32x4 __attribute__((ext_vector_type(4)));
typedef unsigned u32x2 __attribute__((ext_vector_type(2)));

constexpr int NB = 8, SEQ = 2048, DM = 2048, T = NB * SEQ;
constexpr int QKVW = 3072, INC = 15360;
constexpr int O_K = 3072, O_V = 6144, O_Z = 9216, O_G = 11264;
constexpr int BW = 1024;
constexpr int NE = 32, TOPK = 4, EH = 2048;
constexpr float LN_EPS = 1e-5f;
constexpr float ALPHA = 1.189207115002721f;
constexpr int SLOT_CAP = 73728;
constexpr int NWAVES = 8, NTHR = 512;

constexpr size_t MiB = 1u << 20;
constexpr size_t WS_CTL = 0, CTL_ZERO_BYTES = 1 * MiB;
constexpr size_t WS_TOKE = 1 * MiB;
constexpr size_t WS_TOKR = WS_TOKE + 256 * 1024;
constexpr size_t WS_CGB = 1 * MiB + 512 * 1024;
constexpr size_t WS_XS = WS_CGB + 4096;
constexpr size_t WS_WCS = WS_XS + 65536;
constexpr size_t WS_SLOTTOK = 2 * MiB;
constexpr size_t WS_SLOTGATE = 4 * MiB;
constexpr size_t WS_LSE = 6 * MiB;
constexpr size_t WS_WBR = 8 * MiB;
constexpr size_t WS_WOUT = 16 * MiB;
constexpr size_t WS_WIN = 24 * MiB;
constexpr size_t WS_XB = 84 * MiB;
constexpr size_t WS_WGU = 148 * MiB;
constexpr size_t WS_WDN = 660 * MiB;
constexpr size_t WS_P = 916 * MiB;
constexpr size_t WS_OG = 1396 * MiB;
constexpr size_t WS_YA = 1492 * MiB;
constexpr size_t WS_YS = 1524 * MiB;
constexpr size_t WS_T0 = 1556 * MiB;
constexpr size_t WS_MP = 1620 * MiB;
constexpr size_t WS_R1 = 1684 * MiB;
constexpr size_t WS_H = 1812 * MiB;
constexpr size_t WS_HB = 1940 * MiB;
constexpr size_t WS_WG3 = 1940 * MiB + 1 * MiB;
constexpr size_t WS_ACT = 2004 * MiB;
constexpr size_t WS_Y = 2292 * MiB;
constexpr size_t WS_QKV = 2580 * MiB;
constexpr size_t WS_END = 2868 * MiB;
constexpr int CW_BAR = 4096;
constexpr int CW_CNT = 16384;

constexpr int RING_BYTES = 131072;
constexpr int TOKTAB_OFF = RING_BYTES;
constexpr int TOKTAB_UNITS = 20;
constexpr int SMALL_OFF = TOKTAB_OFF + TOKTAB_UNITS * 1024;
constexpr int MISC_OFF = SMALL_OFF + 1024;
constexpr int EPI_OFF = MISC_OFF + 256;
constexpr int LDS_BYTES = EPI_OFF + 4096;

#define RLX_AGENT __ATOMIC_RELAXED, __HIP_MEMORY_SCOPE_AGENT
#define LDS_WAIT() asm volatile("s_waitcnt lgkmcnt(0)" ::: "memory")
#define VM_WAIT() asm volatile("s_waitcnt vmcnt(0)" ::: "memory")
__device__ __forceinline__ unsigned cvt_pk_bf16(float lo, float hi) { unsigned r; asm volatile("v_cvt_pk_bf16_f32 %0, %1, %2" : "=v"(r) : "v"(lo), "v"(hi)); return r; }
__device__ __forceinline__ float bf_lo(unsigned w) { return __uint_as_float(w << 16); }
__device__ __forceinline__ float bf_hi(unsigned w) { return __uint_as_float(w & 0xffff0000u); }
template <int CTRL> __device__ __forceinline__ float dppf(float v) { return __builtin_bit_cast(float, __builtin_amdgcn_update_dpp(0, __builtin_bit_cast(int, v), CTRL, 0xf, 0xf, true)); }
__device__ __forceinline__ float wave_sum(float v) {
    v += dppf<0xB1>(v); v += dppf<0x4E>(v); v += dppf<0x141>(v); v += dppf<0x140>(v);
    { const unsigned b = __builtin_bit_cast(unsigned, v); auto r = __builtin_amdgcn_permlane16_swap(b, b, false, false); v = __builtin_bit_cast(float, (unsigned)r[0]) + __builtin_bit_cast(float, (unsigned)r[1]); }
    { const unsigned b = __builtin_bit_cast(unsigned, v); auto r = __builtin_amdgcn_permlane32_swap(b, b, false, false); v = __builtin_bit_cast(float, (unsigned)r[0]) + __builtin_bit_cast(float, (unsigned)r[1]); }
    return v;
}
__device__ __forceinline__ float wave_max(float v) {
    v = fmaxf(v, dppf<0xB1>(v)); v = fmaxf(v, dppf<0x4E>(v)); v = fmaxf(v, dppf<0x141>(v)); v = fmaxf(v, dppf<0x140>(v));
    { const unsigned b = __builtin_bit_cast(unsigned, v); auto r = __builtin_amdgcn_permlane16_swap(b, b, false, false); v = fmaxf(__builtin_bit_cast(float, (unsigned)r[0]), __builtin_bit_cast(float, (unsigned)r[1])); }
    { const unsigned b = __builtin_bit_cast(unsigned, v); auto r = __builtin_amdgcn_permlane32_swap(b, b, false, false); v = fmaxf(__builtin_bit_cast(float, (unsigned)r[0]), __builtin_bit_cast(float, (unsigned)r[1])); }
    return v;
}
__device__ __forceinline__ float fast_sigmoid(float x) { return __builtin_amdgcn_rcpf(1.0f + __builtin_amdgcn_exp2f(-1.4426950408889634f * x)); }
__device__ __forceinline__ float gelu_tanh(float x) { const float y = 1.5957691216057308f * (x + 0.044715f * x * x * x); return x * fast_sigmoid(y); }
__device__ __forceinline__ unsigned off_b(unsigned row, unsigned ch) { return 256u * row + 16u * (ch ^ (((row & 3) << 2) | ((row >> 2) & 3))); }

#define XB_TMO      128
#define XB_XCNT(j)  (256  + 64 * (j))
#define XB_XSUB(j)  (1280 + 64 * (j))
#define XB_XGEN(j)  (2304 + 64 * (j))
#define XB_TOP      3328
#define XB_TOPGEN   3392
#define XCD_BAR_WORDS 3456
#define XB_SPIN_CAP (1u << 18)
__device__ __forceinline__ unsigned xb_ld(unsigned* p)              { return __hip_atomic_load(p, __ATOMIC_RELAXED, __HIP_MEMORY_SCOPE_AGENT); }
__device__ __forceinline__ unsigned xb_add(unsigned* p, unsigned v) { return __hip_atomic_fetch_add(p, v, __ATOMIC_RELAXED, __HIP_MEMORY_SCOPE_AGENT); }
__device__ __forceinline__ unsigned xb_xcc_id() { return (unsigned)__builtin_amdgcn_s_getreg((3 << 11) | 20) & 0xFu; }
#define XB_SPIN(cond, bar) do { unsigned _sp = 0; while (cond) { __builtin_amdgcn_s_sleep(1); \
    if ((++_sp & 255u) == 0u) { if (xb_ld(&(bar)[XB_TMO])) break; if (_sp > XB_SPIN_CAP) { atomicAdd(&(bar)[XB_TMO], 1u); break; } } } } while (0)
struct XcdBarrier { unsigned* bar; unsigned x; volatile LAS unsigned* st; };
__device__ __forceinline__ XcdBarrier xcd_barrier_post(unsigned* bar, volatile LAS unsigned* st) {
    XcdBarrier b; b.bar = bar; b.x = xb_xcc_id(); b.st = st;
    if (threadIdx.x == 0) (void)xb_add(&bar[XB_XCNT(b.x)], 1u);
    return b;
}
__device__ __forceinline__ void xcd_barrier_complete(unsigned* bar, unsigned x, unsigned& nloc, unsigned& nx) {
    const unsigned G = gridDim.x * gridDim.y * gridDim.z;
    unsigned sum, cnt, mine, sp = 0u;
    for (;;) {
        sum = 0u; cnt = 0u; mine = 0u;
#pragma unroll
        for (unsigned j = 0; j < 16; ++j) { const unsigned c = xb_ld(&bar[XB_XCNT(j)]); sum += c; cnt += (c > 0u) ? 1u : 0u; mine = (j == x) ? c : mine; }
        if (sum == G) break;
        __builtin_amdgcn_s_sleep(1);
        if ((++sp & 255u) == 0u) { if (xb_ld(&bar[XB_TMO])) break; if (sp > XB_SPIN_CAP) { atomicAdd(&bar[XB_TMO], 1u); break; } }
    }
    nloc = mine > 0u ? mine : 1u; nx = cnt > 0u ? cnt : 1u;
}
__device__ __forceinline__ void xcd_barrier(const XcdBarrier& b) {
    asm volatile("s_waitcnt vmcnt(0)" ::: "memory");
    __syncthreads();
    if (threadIdx.x == 0) {
        unsigned* bar = b.bar;
        __builtin_amdgcn_s_waitcnt(0);
        unsigned nloc = b.st[0], nx = b.st[1];
        if (nloc == 0u) { xcd_barrier_complete(bar, b.x, nloc, nx); b.st[0] = nloc; b.st[1] = nx; }
        const unsigned old = xb_add(&bar[XB_XSUB(b.x)], 1u);
        const unsigned gen = old / nloc;
        if (old + 1u == (gen + 1u) * nloc) {
            __builtin_amdgcn_fence(__ATOMIC_RELEASE, "agent");
            asm volatile("s_waitcnt vmcnt(0)" ::: "memory");
            const unsigned og = xb_add(&bar[XB_TOP], 1u);
            const unsigned tg = og / nx;
            if (og + 1u == (tg + 1u) * nx) xb_add(&bar[XB_TOPGEN], 1u);
            else XB_SPIN(xb_ld(&bar[XB_TOPGEN]) == tg, bar);
            __builtin_amdgcn_fence(__ATOMIC_ACQUIRE, "agent");
            xb_add(&bar[XB_XGEN(b.x)], 1u);
            asm volatile("s_waitcnt vmcnt(0)" ::: "memory");
        } else {
            XB_SPIN(xb_ld(&bar[XB_XGEN(b.x)]) == gen, bar);
            __builtin_amdgcn_fence(__ATOMIC_ACQUIRE, "agent");
            asm volatile("s_waitcnt vmcnt(0)" ::: "memory");
        }
    }
    __syncthreads();
}

namespace pg8 {
constexpr int BM = 256, BK = 64, HALF = 128, HTB = HALF * BK * 2, STAGE_BYTES = 8 * HTB, NXCD = 8, WGM = 8;
__device__ __forceinline__ int lds_byte(int r, int c) { const int st = (r >> 4) * 2 + (c >> 5), rr = r & 15, cc = c & 31, ob = rr * 64 + cc * 2; return st * 1024 + (ob ^ (((ob >> 9) & 1) << 5)); }
__device__ __forceinline__ void stage_rc(int b, int& R, int& C) { const int st = b / 1024, sb = b % 1024, swz = sb ^ (((sb >> 9) & 1) << 5); R = (st >> 1) * 16 + swz / 64; C = (st & 1) * 32 + (swz % 64) / 2; }
__device__ __forceinline__ int perm32(int rho) { const int n = rho >> 4, i = rho & 15; return 8 * (i >> 2) + 4 * n + (i & 3); }

struct Unit { int pm, pn, e, ord; };

__device__ __forceinline__ int xcd_remap(int L, int nwg) { const int q = nwg / NXCD, r = nwg % NXCD, xcd = L % NXCD, off = L / NXCD; return (xcd < r ? xcd * (q + 1) : r * (q + 1) + (xcd - r) * q) + off; }

template <int DT> struct DenseT {
    static constexpr bool GATHER = false, FP8 = (DT == 1), I8 = (DT == 2);
    const bf16_t* A; const bf16_t* Bt; int K; int nM, nN, nwg, G, c, i0, i1, pn_off, gap_lo, gap_n, rep, ranged;
    __device__ void init(const bf16_t* A_, const bf16_t* Bt_, int M, int N, int K_, int G_, int c_) { A = A_; Bt = Bt_; K = K_; nM = M / BM; nN = N / BM; nwg = nM * nN; G = G_; c = c_; i0 = 0; i1 = 1 << 28; pn_off = 0; gap_lo = 1 << 28; gap_n = 0; rep = 1; ranged = 0; }
    __device__ __forceinline__ bool next(int i_, Unit& u) const {
        const int i = i_ + i0; const long L = (long)i * G + c; if (i >= i1 || L >= (long)nwg * rep) return false;
        if (ranged) {
            int l = (int)(L % nwg); const int U0 = nM * 16, U1 = nM * 36; int pn0 = 44, nNr = 16;
            if (l >= U0 + U1) { l -= U0 + U1; pn0 = 36; nNr = 8; } else if (l >= U0) { l -= U0; pn0 = 0; nNr = 36; }
            const int wgid = xcd_remap(l, nM * nNr), nig = WGM * nNr, gid = wgid / nig, fm = gid * WGM, gsz = (nM - fm) < WGM ? (nM - fm) : WGM;
            u.pm = fm + ((wgid % nig) % gsz); u.pn = pn0 + (wgid % nig) / gsz; u.e = 0; u.ord = i; return true; }
        const int wgid = xcd_remap((int)(L % nwg), nwg);
        const int nig = WGM * nN, gid = wgid / nig, fm = gid * WGM, gsz = (nM - fm) < WGM ? (nM - fm) : WGM;
        u.pm = fm + ((wgid % nig) % gsz); u.pn = (wgid % nig) / gsz + pn_off; if (u.pn >= gap_lo) u.pn += gap_n; u.e = 0; u.ord = i; return true;
    }
    __device__ __forceinline__ bool half_only(const Unit&) const { return false; }
    __device__ __forceinline__ const char* a_base(const Unit& u) const { return (const char*)A + (size_t)u.pm * BM * K * 2; }
    __device__ __forceinline__ const char* b_base(const Unit& u) const { return (const char*)Bt + (size_t)(u.pn - pn_off) * BM * K * 2; }
    __device__ __forceinline__ void a_offs(const Unit&, const int (&R)[2], const int (&C)[2], unsigned (&vo)[2][2]) const {
#pragma unroll
        for (int h = 0; h < 2; ++h)
#pragma unroll
            for (int i = 0; i < 2; ++i) vo[h][i] = (unsigned)((R[i] + h * HALF) * K + C[i]) * 2u;
    }
};
typedef DenseT<0> Dense; typedef DenseT<1> Dense8; typedef DenseT<2> DenseI8;
constexpr int MOE_MAX_UNITS = 20;
template <bool GATHER_, bool FP8_> struct Moe {
    static constexpr bool GATHER = GATHER_, FP8 = FP8_, I8 = false;
    const bf16_t* A; const bf16_t* Bt; int K; int nN, G, c, i0, i1, rep; const LAS int* tpre; const LAS int* toktab; const LAS int* cnt; const LAS int* utab;
    __device__ __forceinline__ bool scan(int i, Unit& u) const {
        const int nwg = tpre[NE] * nN; const long L = (long)i * G + c; if (L >= (long)nwg * rep) return false;
        const int w = xcd_remap((int)(L % nwg), nwg);
        int e = 0;
        while (e < NE - 1 && tpre[e + 1] * nN <= w) ++e;
        const int te = tpre[e + 1] - tpre[e], local = w - tpre[e] * nN;
        u.e = e; u.pn = local / te; u.pm = local % te; u.ord = i; return true;
    }
    __device__ __forceinline__ void fill_units(int tid) const {
        LAS int* ut = (LAS int*)utab;
        if (tid < MOE_MAX_UNITS) { Unit u; const bool ok = scan(tid, u); ut[tid * 4] = ok ? u.e : -1; ut[tid * 4 + 1] = u.pm; ut[tid * 4 + 2] = u.pn; }
        __syncthreads();
    }
    __device__ __forceinline__ bool next(int i_, Unit& u) const {
        const int i = i_ + i0; if (i >= i1 || i >= MOE_MAX_UNITS) return false;
        const int e = __builtin_amdgcn_readfirstlane(utab[i * 4]); if (e < 0) return false;
        u.e = e; u.pm = __builtin_amdgcn_readfirstlane(utab[i * 4 + 1]); u.pn = __builtin_amdgcn_readfirstlane(utab[i * 4 + 2]); u.ord = i; return true;
    }
    __device__ __forceinline__ bool half_only(const Unit& u) const { return cnt[u.e] - u.pm * BM <= HALF; }
    __device__ __forceinline__ const char* a_base(const Unit& u) const { return GATHER ? (const char*)A : (const char*)A + (size_t)(tpre[u.e] + u.pm) * BM * K * 2; }
    __device__ __forceinline__ const char* b_base(const Unit& u) const { return (const char*)Bt + ((size_t)u.e * nN + u.pn) * BM * K * 2; }
    __device__ __forceinline__ void a_offs(const Unit& u, const int (&R)[2], const int (&C)[2], unsigned (&vo)[2][2]) const {
#pragma unroll
        for (int h = 0; h < 2; ++h)
#pragma unroll
            for (int i = 0; i < 2; ++i) {
                if (GATHER) { const int tok = toktab[u.ord * 256 + R[i] + h * HALF]; vo[h][i] = (unsigned)(tok * K + C[i]) * 2u; }
                else vo[h][i] = (unsigned)((R[i] + h * HALF) * K + C[i]) * 2u;
            }
    }
};

typedef int i32x8 __attribute__((ext_vector_type(8)));
typedef int i32x4 __attribute__((ext_vector_type(4)));
__device__ __forceinline__ i32x8 cat8(bf16x8 lo, bf16x8 hi) { return __builtin_shufflevector(__builtin_bit_cast(i32x4, lo), __builtin_bit_cast(i32x4, hi), 0, 1, 2, 3, 4, 5, 6, 7); }
constexpr float W8_MUL = 64.0f, W8_INV = 1.0f / 64.0f;
constexpr float Y_MUL = 16.0f;
constexpr float T0_MUL = 16.0f;
constexpr float YS_MUL = 16.0f;
constexpr float MP_MUL = 16.0f;
constexpr float YA_MUL = 16.0f;
template <class Epi, class Prob>
__device__ __forceinline__ void gemm_phase(LAS unsigned char* lds, const Prob& S, const Epi& E) {
    int tid_ = threadIdx.x; asm volatile("" : "+v"(tid_));
    const int tid = tid_, wid = __builtin_amdgcn_readfirstlane(tid >> 6), lane = tid & 63, wr = wid >> 2, wc = wid & 3, fr = lane & 15, fq = lane >> 4;
    const int K = S.K, nt = K / BK;
    int Rp[2], Cp[2]; unsigned voffB[2];
#pragma unroll
    for (int i = 0; i < 2; ++i) { int R, C; stage_rc(tid * 16 + i * 8192, R, C); Rp[i] = R; Cp[i] = C; const int Rb = Epi::PERM ? ((R & ~31) + perm32(R & 31)) : R; voffB[i] = (unsigned)(Rb * K + C) * 2u; }
    const size_t kstep = (size_t)(BK * 2);
    const size_t hstep = (size_t)HALF * K * 2;
    const unsigned ldsw = (unsigned)wid * 1024u;
    const int aoff = lds_byte(wr * 64 + fr, fq * 8), boff = lds_byte(wc * 32 + fr, fq * 8);
#define PG8_SA(b, h) (((b) * 2 + (h)) * HTB)
#define PG8_SB(b, h) ((4 + (b) * 2 + (h)) * HTB)
#define PG8_STAGE(bufoff, gbase, voff) do { _Pragma("unroll") for (int _i = 0; _i < 2; ++_i) \
        __builtin_amdgcn_global_load_lds((const unsigned*)((const char*)(gbase) + (voff)[_i]), (LAS unsigned*)(lds + (bufoff) + ldsw + _i * 8192), 16, 0, 0); } while (0)
#define PG8_LDA(dst, b, h) do { if constexpr (Prob::FP8) { _Pragma("unroll") for (int m = 0; m < 4; ++m) dst##8[m] = cat8(*(const LAS bf16x8*)(lds + PG8_SA(b, h) + aoff + m * 2048), *(const LAS bf16x8*)(lds + PG8_SA(b, h) + aoff + m * 2048 + 1024)); } \
        else { _Pragma("unroll") for (int m = 0; m < 4; ++m) _Pragma("unroll") for (int k = 0; k < 2; ++k) dst[m][k] = *(const LAS bf16x8*)(lds + PG8_SA(b, h) + aoff + m * 2048 + k * 1024); } } while (0)
#define PG8_LDB(dst, b, h) do { if constexpr (Prob::FP8) { _Pragma("unroll") for (int n = 0; n < 2; ++n) dst##8[n] = cat8(*(const LAS bf16x8*)(lds + PG8_SB(b, h) + boff + n * 2048), *(const LAS bf16x8*)(lds + PG8_SB(b, h) + boff + n * 2048 + 1024)); } \
        else { _Pragma("unroll") for (int n = 0; n < 2; ++n) _Pragma("unroll") for (int k = 0; k < 2; ++k) dst[n][k] = *(const LAS bf16x8*)(lds + PG8_SB(b, h) + boff + n * 2048 + k * 1024); } } while (0)
#define PG8_MMA(ai, bj, At, Bt) do { __builtin_amdgcn_s_setprio(1); \
        if constexpr (Prob::FP8) { _Pragma("unroll") for (int m = 0; m < 4; ++m) _Pragma("unroll") for (int n = 0; n < 2; ++n) \
            asm("v_mfma_f32_16x16x128_f8f6f4 %0, %1, %2, %0" : "+v"(acc[ai][bj][m][n]) : "v"(Bt##8[n]), "v"(At##8[m])); } \
        else if constexpr (Prob::I8) { _Pragma("unroll") for (int m = 0; m < 4; ++m) _Pragma("unroll") for (int n = 0; n < 2; ++n) _Pragma("unroll") for (int k = 0; k < 2; ++k) \
            acc[ai][bj][m][n] = __builtin_bit_cast(f32x4, __builtin_amdgcn_mfma_i32_16x16x64_i8(__builtin_bit_cast(i32x4, Bt[n][k]), __builtin_bit_cast(i32x4, At[m][k]), __builtin_bit_cast(i32x4, acc[ai][bj][m][n]), 0, 0, 0)); } \
        else { _Pragma("unroll") for (int m = 0; m < 4; ++m) _Pragma("unroll") for (int n = 0; n < 2; ++n) _Pragma("unroll") for (int k = 0; k < 2; ++k) \
            acc[ai][bj][m][n] = __builtin_amdgcn_mfma_f32_16x16x32_bf16(Bt[n][k], At[m][k], acc[ai][bj][m][n], 0, 0, 0); } \
        __builtin_amdgcn_s_setprio(0); } while (0)
#define PG8_WAIT_V(n) asm volatile("s_waitcnt vmcnt(" #n ")" ::: "memory")
#define PG8_WAIT_L(n) asm volatile("s_waitcnt lgkmcnt(" #n ")" ::: "memory")
#define PG8_BAR __builtin_amdgcn_s_barrier()
#define PG8_SCHED __builtin_amdgcn_sched_barrier(0)
    Unit cur, nxt; int ui = 0;
    if (!S.next(0, cur)) return;
    LAS float* epi_tab = (LAS float*)(lds + EPI_OFF);
    if constexpr (Epi::HAS_PRE) __builtin_amdgcn_global_load_lds((const unsigned*)E.pre_src(cur, tid), (LAS unsigned*)(epi_tab + wid * 64), 4, 0, 0);
    f32x4 acc[2][2][4][2];
#pragma unroll
    for (int a = 0; a < 2; ++a)
#pragma unroll
        for (int b = 0; b < 2; ++b)
#pragma unroll
            for (int m = 0; m < 4; ++m)
#pragma unroll
                for (int n = 0; n < 2; ++n) acc[a][b][m][n] = (f32x4){0.f, 0.f, 0.f, 0.f};
    bf16x8 At[4][2], B0[2][2], B1[2][2]; i32x8 At8[4], B08[2], B18[2];
    unsigned voA[2][2], nvoA[2][2];
    S.a_offs(cur, Rp, Cp, voA);
    if constexpr (Prob::GATHER) { LDS_WAIT(); }
    const char* cA = S.a_base(cur); const char* cB = S.b_base(cur);
    PG8_STAGE(PG8_SB(0, 0), cB, voffB); PG8_STAGE(PG8_SB(0, 1), cB + hstep, voffB); PG8_STAGE(PG8_SA(0, 0), cA, voA[0]); PG8_STAGE(PG8_SA(0, 1), cA, voA[1]);
    if (wr == 1) PG8_BAR;
    PG8_WAIT_V(2); PG8_BAR;
    PG8_STAGE(PG8_SB(1, 0), cB + kstep, voffB); PG8_STAGE(PG8_SA(1, 0), cA + kstep, voA[0]); PG8_STAGE(PG8_SB(1, 1), cB + hstep + kstep, voffB);
    PG8_WAIT_V(6); PG8_BAR;
    for (;;) {
        const bool has_next = S.next(ui + 1, nxt);
        const bool half = __builtin_amdgcn_readfirstlane((int)S.half_only(cur)) != 0;
        const char* nA = has_next ? S.a_base(nxt) : cA; const char* nB = has_next ? S.b_base(nxt) : cB;
        if constexpr (Prob::GATHER) {
            if (has_next) S.a_offs(nxt, Rp, Cp, nvoA);
            else {
#pragma unroll
                for (int h = 0; h < 2; ++h)
#pragma unroll
                    for (int i = 0; i < 2; ++i) nvoA[h][i] = voA[h][i];
            }
        }
        for (int t = 0; t < nt; t += 2) {
            const bool last = (t == nt - 2);
            const char* a1 = cA + (size_t)(t + 1) * kstep;
            const char* a2 = last ? nA : cA + (size_t)(t + 2) * kstep; const char* b2 = last ? nB : cB + (size_t)(t + 2) * kstep;
            const char* a3 = a2 + kstep; const char* b3 = b2 + kstep;
            unsigned vo2[2][2];
#pragma unroll
            for (int h = 0; h < 2; ++h)
#pragma unroll
                for (int i = 0; i < 2; ++i) { if constexpr (Prob::GATHER) vo2[h][i] = last ? nvoA[h][i] : voA[h][i]; else vo2[h][i] = voA[h][i]; }
            PG8_LDB(B0, 0, 0); PG8_LDB(B1, 0, 1); PG8_SCHED; PG8_LDA(At, 0, 0); PG8_STAGE(PG8_SA(1, 1), a1, voA[1]);
            PG8_WAIT_V(8); PG8_WAIT_L(0); PG8_BAR; PG8_MMA(0, 0, At, B0); PG8_MMA(0, 1, At, B1); PG8_BAR; PG8_SCHED;
            PG8_LDA(At, 0, 1); PG8_STAGE(PG8_SB(0, 0), b2, voffB); PG8_STAGE(PG8_SB(0, 1), b2 + hstep, voffB); PG8_STAGE(PG8_SA(0, 0), a2, vo2[0]);
            PG8_WAIT_V(8); PG8_WAIT_L(0); PG8_BAR; if (!half) { PG8_MMA(1, 0, At, B0); PG8_MMA(1, 1, At, B1); } PG8_BAR; PG8_SCHED;
            PG8_LDB(B0, 1, 0); PG8_LDB(B1, 1, 1); PG8_SCHED; PG8_LDA(At, 1, 0); PG8_STAGE(PG8_SA(0, 1), a2, vo2[1]);
            PG8_WAIT_V(8); PG8_WAIT_L(0); PG8_BAR; PG8_MMA(0, 0, At, B0); PG8_MMA(0, 1, At, B1); PG8_BAR; PG8_SCHED;
            PG8_LDA(At, 1, 1); PG8_STAGE(PG8_SB(1, 0), b3, voffB); PG8_STAGE(PG8_SB(1, 1), b3 + hstep, voffB); PG8_STAGE(PG8_SA(1, 0), a3, vo2[0]);
            PG8_WAIT_V(8); PG8_WAIT_L(0); PG8_BAR; if (!half) { PG8_MMA(1, 0, At, B0); PG8_MMA(1, 1, At, B1); } PG8_BAR; PG8_SCHED;
        }
        if constexpr (Epi::HAS_PRE) { if (has_next) __builtin_amdgcn_global_load_lds((const unsigned*)E.pre_src(nxt, tid), (LAS unsigned*)(epi_tab + ((ui + 1) & 1) * 512 + wid * 64), 4, 0, 0); }
        if (wr == 0) PG8_BAR;
        if constexpr (Prob::FP8) asm volatile("s_nop 15\n\ts_nop 15" ::: "memory");
        if constexpr (Epi::HAS_PRE) E.run(acc, cur, wr, wc, fr, fq, epi_tab + (ui & 1) * 512);
        else E(acc, cur, wr, wc, fr, fq);
        if (!has_next) break;
#pragma unroll
        for (int a = 0; a < 2; ++a)
#pragma unroll
            for (int b = 0; b < 2; ++b)
#pragma unroll
                for (int m = 0; m < 4; ++m)
#pragma unroll
                    for (int n = 0; n < 2; ++n) acc[a][b][m][n] = (f32x4){0.f, 0.f, 0.f, 0.f};
        cur = nxt; cA = nA; cB = nB; ++ui;
        if constexpr (Prob::GATHER) {
#pragma unroll
            for (int h = 0; h < 2; ++h)
#pragma unroll
                for (int i = 0; i < 2; ++i) voA[h][i] = nvoA[h][i];
        }
        if (wr == 1) PG8_BAR;
    }
    PG8_WAIT_V(0);
    PG8_BAR;
#undef PG8_SA
#undef PG8_SB
#undef PG8_STAGE
#undef PG8_LDA
#undef PG8_LDB
#undef PG8_MMA
#undef PG8_WAIT_V
#undef PG8_WAIT_L
#undef PG8_BAR
#undef PG8_SCHED
}

constexpr float V8_MUL = 16.0f;
__device__ __forceinline__ unsigned pk4_fp8(float a, float b, float c, float d) { int p = __builtin_amdgcn_cvt_pk_fp8_f32(a, b, 0, false); p = __builtin_amdgcn_cvt_pk_fp8_f32(c, d, p, true); return (unsigned)p; }
__device__ __forceinline__ u32x4 pair_rows16(u32x2 wa, u32x2 wb) {
    auto rx = __builtin_amdgcn_permlane16_swap(wa.x, wb.x, false, false); auto ry = __builtin_amdgcn_permlane16_swap(wa.y, wb.y, false, false);
    u32x4 o; o.x = rx[0]; o.y = ry[0]; o.z = rx[1]; o.w = ry[1]; return o; }
template <bool I8> struct EpiProjT {
    static constexpr bool PERM = true, HAS_PRE = I8;
    bf16_t* P; bf16_t* QKV; float sc; const float* rs; const float* cs;
    __device__ __forceinline__ f32x4 val(const f32x4& a, const f32x4& scl) const {
        if (I8) { const i32x4 ai = __builtin_bit_cast(i32x4, a); return (f32x4){(float)ai[0], (float)ai[1], (float)ai[2], (float)ai[3]} * scl; }
        return a * scl; }
    __device__ __forceinline__ const float* pre_src(const Unit& u, int tid) const { return tid < 256 ? rs + u.pm * BM + tid : cs + u.pn * BM + tid - 256; }
    __device__ __forceinline__ void run(const f32x4 (&acc)[2][2][4][2], const Unit& u, int wr, int wc, int fr, int fq, const LAS float* tab) const { body(acc, u, wr, wc, fr, fq, tab); }
    __device__ __forceinline__ void operator()(const f32x4 (&acc)[2][2][4][2], const Unit& u, int wr, int wc, int fr, int fq) const { body(acc, u, wr, wc, fr, fq, nullptr); }
    __device__ __forceinline__ void body(const f32x4 (&acc)[2][2][4][2], const Unit& u, int wr, int wc, int fr, int fq, const LAS float* tab) const {
        const int row0 = u.pm * BM + wr * 64 + fr, col0 = u.pn * BM + wc * 32 + 8 * fq;
        const int mode = u.pn < 36 ? 0 : (u.pn < 44 ? 1 : 2);
        f32x4 cs0[2], cs1[2];
#pragma unroll
        for (int bj = 0; bj < 2; ++bj) { if (I8) { cs0[bj] = *(const LAS f32x4*)(tab + 256 + wc * 32 + 8 * fq + bj * HALF); cs1[bj] = *(const LAS f32x4*)(tab + 256 + wc * 32 + 8 * fq + bj * HALF + 4); } else { cs0[bj] = (f32x4){sc, sc, sc, sc}; cs1[bj] = cs0[bj]; } }
        float rsv[2][4];
#pragma unroll
        for (int ai = 0; ai < 2; ++ai)
#pragma unroll
            for (int m = 0; m < 4; ++m) rsv[ai][m] = I8 ? tab[wr * 64 + fr + ai * HALF + m * 16] : 1.0f;
        if (mode == 0) {
            const int which = u.pn / 12, rem = u.pn % 12, g = rem >> 2, hp = rem & 3, lr = 2 * g;
            constexpr size_t WHQ = (size_t)3 * 8 * 8 * 2048 * 128;
#pragma unroll
            for (int ai = 0; ai < 2; ++ai) { u32x2 v8w[4][2]; int v8p[4], v8b[4];
#pragma unroll
                for (int m = 0; m < 4; ++m) { const int t = row0 + ai * HALF + m * 16, b = t >> 11, pos = t & 2047;
                    const int pp = ((pos & ((1 << lr) - 1)) << (11 - lr)) + (pos >> lr);
#pragma unroll
                    for (int bj = 0; bj < 2; ++bj) { const f32x4 v0 = val(acc[ai][bj][m][0], cs0[bj] * rsv[ai][m]), v1 = val(acc[ai][bj][m][1], cs1[bj] * rsv[ai][m]);
                        if (true) {
                            v8w[m][bj].x = pk4_fp8(v0[0] * V8_MUL, v0[1] * V8_MUL, v0[2] * V8_MUL, v0[3] * V8_MUL); v8w[m][bj].y = pk4_fp8(v1[0] * V8_MUL, v1[1] * V8_MUL, v1[2] * V8_MUL, v1[3] * V8_MUL);
                            v8p[m] = pp; v8b[m] = b;
                            if (m & 1) { const int odd = fq & 1; const u32x4 o = pair_rows16(v8w[m - 1][bj], v8w[m][bj]);
                                *(u32x4*)((unsigned char*)(QKV + which * WHQ) + ((((size_t)g * 8 + hp * 2 + bj) * 8 + v8b[m - 1 + odd]) * 2048 + v8p[m - 1 + odd]) * 128 + wc * 32 + 8 * fq - 8 * odd) = o; }
                            continue; }
                        u32x4 w; w.x = cvt_pk_bf16(v0[0], v0[1]); w.y = cvt_pk_bf16(v0[2], v0[3]); w.z = cvt_pk_bf16(v1[0], v1[1]); w.w = cvt_pk_bf16(v1[2], v1[3]);
                        *(u32x4*)(QKV + ((((size_t)(which * 3 + g) * 8 + hp * 2 + bj) * 8 + b) * 2048 + pp) * 128 + wc * 32 + 8 * fq) = w; } } }
            return;
        }
        if (mode == 1) tail<1>(acc, row0, col0, cs0, cs1, rsv); else tail<2>(acc, row0, col0, cs0, cs1, rsv);
    }
    template <int MODE> __device__ __forceinline__ void tail(const f32x4 (&acc)[2][2][4][2], int row0, int col0, const f32x4 (&cs0)[2], const f32x4 (&cs1)[2], const float (&rsv)[2][4]) const {
#pragma unroll
        for (int ai = 0; ai < 2; ++ai)
#pragma unroll
            for (int m = 0; m < 4; ++m) { bf16_t* rowp = P + (size_t)(row0 + ai * HALF + m * 16) * INC + col0;
#pragma unroll
                for (int bj = 0; bj < 2; ++bj) { constexpr float C1 = -1.5957691216057308f * 1.4426950408889634f, C3 = 0.044715f * C1, CS = MODE == 1 ? 1.0f : -1.4426950408889634f;
                    f32x4 v0 = val(acc[ai][bj][m][0], cs0[bj] * (rsv[ai][m] * CS)), v1 = val(acc[ai][bj][m][1], cs1[bj] * (rsv[ai][m] * CS));
                    f32x4 e0, e1;
                    if (MODE == 1) { e0 = (v0 * v0 * C3 + C1) * v0; e1 = (v1 * v1 * C3 + C1) * v1; } else { e0 = v0; e1 = v1; }
#pragma unroll
                    for (int j = 0; j < 4; ++j) { e0[j] = __builtin_amdgcn_exp2f(e0[j]); e1[j] = __builtin_amdgcn_exp2f(e1[j]); }
                    e0 = e0 + 1.0f; e1 = e1 + 1.0f;
#pragma unroll
                    for (int j = 0; j < 4; ++j) { e0[j] = __builtin_amdgcn_rcpf(e0[j]); e1[j] = __builtin_amdgcn_rcpf(e1[j]); }
                    if (MODE == 1) { v0 = v0 * e0; v1 = v1 * e1; } else { v0 = e0; v1 = e1; }
                    u32x4 w; w.x = cvt_pk_bf16(v0[0], v0[1]); w.y = cvt_pk_bf16(v0[2], v0[3]); w.z = cvt_pk_bf16(v1[0], v1[1]); w.w = cvt_pk_bf16(v1[2], v1[3]);
                    *(u32x4*)(rowp + bj * HALF) = w; } }
    }
};
typedef EpiProjT<false> EpiProj;
template <int BR> struct EpiBranch {
    static constexpr bool PERM = true, HAS_PRE = false;
    const bf16_t* P; bf16_t* t0; bf16_t* mp; float sc;
    __device__ __forceinline__ void operator()(const f32x4 (&acc)[2][2][4][2], const Unit& u, int wr, int wc, int fr, int fq) const {
        const int row0 = u.pm * BM + wr * 64 + fr, col0 = u.pn * BM + wc * 32 + 8 * fq;
#pragma unroll
        for (int ai = 0; ai < 2; ++ai) {
            u32x4 gv[4][2], pv[4][2];
#pragma unroll
            for (int m = 0; m < 4; ++m) { const size_t row = (size_t)(row0 + ai * HALF + m * 16);
#pragma unroll
                for (int bj = 0; bj < 2; ++bj) { const int col = col0 + bj * HALF; gv[m][bj] = *(const u32x4*)(P + row * INC + O_G + BR * DM + col);
                    if (BR == 1) { if (T0_FP8) { const u32x2 q = *(const u32x2*)((const unsigned char*)t0 + row * DM + col); pv[m][bj].x = q.x; pv[m][bj].y = q.y; } else pv[m][bj] = *(const u32x4*)(t0 + row * DM + col); } } }
            u32x2 wm8[4][2];
#pragma unroll
            for (int m = 0; m < 4; ++m) { const size_t row = (size_t)(row0 + ai * HALF + m * 16);
#pragma unroll
                for (int bj = 0; bj < 2; ++bj) { const int col = col0 + bj * HALF; const u32x4 g = gv[m][bj];
                    f32x4 v0 = acc[ai][bj][m][0] * sc, v1 = acc[ai][bj][m][1] * sc;
                    v0[0] *= bf_lo(g.x); v0[1] *= bf_hi(g.x); v0[2] *= bf_lo(g.y); v0[3] *= bf_hi(g.y);
                    v1[0] *= bf_lo(g.z); v1[1] *= bf_hi(g.z); v1[2] *= bf_lo(g.w); v1[3] *= bf_hi(g.w);
                    if (BR == 1) { const u32x4 p = pv[m][bj];
                        if (T0_FP8) { const f32x2 a = __builtin_amdgcn_cvt_pk_f32_fp8((int)p.x, false), b = __builtin_amdgcn_cvt_pk_f32_fp8((int)p.x, true), c = __builtin_amdgcn_cvt_pk_f32_fp8((int)p.y, false), d = __builtin_amdgcn_cvt_pk_f32_fp8((int)p.y, true);
                            v0[0] += a[0] * (1.0f / T0_MUL); v0[1] += a[1] * (1.0f / T0_MUL); v0[2] += b[0] * (1.0f / T0_MUL); v0[3] += b[1] * (1.0f / T0_MUL);
                            v1[0] += c[0] * (1.0f / T0_MUL); v1[1] += c[1] * (1.0f / T0_MUL); v1[2] += d[0] * (1.0f / T0_MUL); v1[3] += d[1] * (1.0f / T0_MUL); }
                        else {
                        v0[0] += bf_lo(p.x); v0[1] += bf_hi(p.x); v0[2] += bf_lo(p.y); v0[3] += bf_hi(p.y);
                        v1[0] += bf_lo(p.z); v1[1] += bf_hi(p.z); v1[2] += bf_lo(p.w); v1[3] += bf_hi(p.w); } }
                    if ((BR == 1 && P5_FP8) || (BR == 0 && T0_FP8)) { constexpr float OM = BR == 1 ? MP_MUL : T0_MUL;
                        wm8[m][bj].x = pk4_fp8(v0[0] * OM, v0[1] * OM, v0[2] * OM, v0[3] * OM); wm8[m][bj].y = pk4_fp8(v1[0] * OM, v1[1] * OM, v1[2] * OM, v1[3] * OM);
                        if (m & 1) { const int odd = fq & 1; const u32x4 o = pair_rows16(wm8[m - 1][bj], wm8[m][bj]);
                            *(u32x4*)((unsigned char*)(BR == 1 ? mp : t0) + (size_t)(row0 + ai * HALF + (m - 1 + odd) * 16) * DM + col - 8 * odd) = o; } }
                    else { u32x4 w; w.x = cvt_pk_bf16(v0[0], v0[1]); w.y = cvt_pk_bf16(v0[2], v0[3]); w.z = cvt_pk_bf16(v1[0], v1[1]); w.w = cvt_pk_bf16(v1[2], v1[3]);
                        *(u32x4*)((BR == 0 ? t0 : mp) + row * DM + col) = w; } } } }
    }
};
struct EpiOut {
    static constexpr bool PERM = false, HAS_PRE = false;
    const float* x; float* r1; float sc;
    __device__ __forceinline__ void operator()(const f32x4 (&acc)[2][2][4][2], const Unit& u, int wr, int wc, int fr, int fq) const {
        const int row0 = u.pm * BM + wr * 64 + fr, col0 = u.pn * BM + wc * 32 + 4 * fq;
#pragma unroll
        for (int ai = 0; ai < 2; ++ai) {
            f32x4 xv[4][2][2];
#pragma unroll
            for (int m = 0; m < 4; ++m) { const size_t off = (size_t)(row0 + ai * HALF + m * 16) * DM + col0;
#pragma unroll
                for (int bj = 0; bj < 2; ++bj)
#pragma unroll
                    for (int n = 0; n < 2; ++n) xv[m][bj][n] = __builtin_nontemporal_load((const f32x4*)(x + off + bj * HALF + n * 16)); }
#pragma unroll
            for (int m = 0; m < 4; ++m) { const size_t off = (size_t)(row0 + ai * HALF + m * 16) * DM + col0;
#pragma unroll
                for (int bj = 0; bj < 2; ++bj) {
                    u32x2 w[2];
#pragma unroll
                    for (int n = 0; n < 2; ++n) { const f32x4 r = xv[m][bj][n] * ALPHA + acc[ai][bj][m][n] * sc; w[n].x = cvt_pk_bf16(r[0], r[1]); w[n].y = cvt_pk_bf16(r[2], r[3]); }
                    const int odd = fq & 1; const u32x4 o = pair_rows16(w[0], w[1]);
                    *(u32x4*)((bf16_t*)r1 + off + bj * HALF + 16 * odd - 4 * odd) = o; } } }
    }
};
__device__ __forceinline__ unsigned pack4_fp8(float a, float b, float c, float d) { int p = __builtin_amdgcn_cvt_pk_fp8_f32(a, b, 0, false); p = __builtin_amdgcn_cvt_pk_fp8_f32(c, d, p, true); return (unsigned)p; }
struct EpiGU {
    static constexpr bool PERM = true, HAS_PRE = true;
    const float* bgu; unsigned char* act; const LAS int* tpre;
    __device__ __forceinline__ const float* pre_src(const Unit& u, int tid) const {
        return bgu + (size_t)u.e * 2 * EH + ((tid >> 7) & 1) * EH + u.pn * HALF + (tid & 127); }
    __device__ __forceinline__ void run(const f32x4 (&acc)[2][2][4][2], const Unit& u, int wr, int wc, int fr, int fq, const LAS float* tab) const {
        const int row0 = (tpre[u.e] + u.pm) * BM + wr * 64 + fr, col0 = u.pn * HALF + wc * 32 + 8 * fq;
        const LAS float* bg = tab + wc * 32 + 8 * fq;
        const f32x4 bg0 = *(const LAS f32x4*)(bg), bg1 = *(const LAS f32x4*)(bg + 4), bl0 = *(const LAS f32x4*)(bg + HALF) + 1.0f, bl1 = *(const LAS f32x4*)(bg + HALF + 4) + 1.0f;
        constexpr float KS = -1.702f * 1.4426950408889634f;
        const int odd = fq & 1;
#pragma unroll
        for (int ai = 0; ai < 2; ++ai) { u32x2 wm[4];
#pragma unroll
            for (int m = 0; m < 4; ++m) {
                f32x4 ga = acc[ai][0][m][0] * W8_INV + bg0, gb = acc[ai][0][m][1] * W8_INV + bg1, la = acc[ai][1][m][0] * W8_INV + bl0, lb = acc[ai][1][m][1] * W8_INV + bl1;
#pragma unroll
                for (int j = 0; j < 4; ++j) { ga[j] = fminf(ga[j], 7.0f); gb[j] = fminf(gb[j], 7.0f); la[j] = __builtin_amdgcn_fmed3f(la[j], -6.0f, 8.0f); lb[j] = __builtin_amdgcn_fmed3f(lb[j], -6.0f, 8.0f); }
                f32x4 ea = ga * KS, eb = gb * KS;
#pragma unroll
                for (int j = 0; j < 4; ++j) { ea[j] = __builtin_amdgcn_exp2f(ea[j]); eb[j] = __builtin_amdgcn_exp2f(eb[j]); }
                ea = ea + 1.0f; eb = eb + 1.0f;
#pragma unroll
                for (int j = 0; j < 4; ++j) { ea[j] = __builtin_amdgcn_rcpf(ea[j]); eb[j] = __builtin_amdgcn_rcpf(eb[j]); }
                const f32x4 o0 = ga * ea * la, o1 = gb * eb * lb;
                wm[m].x = pack4_fp8(o0[0], o0[1], o0[2], o0[3]); wm[m].y = pack4_fp8(o1[0], o1[1], o1[2], o1[3]);
                if (m & 1) { const u32x4 o = pair_rows16(wm[m - 1], wm[m]);
                    *(u32x4*)(act + (size_t)(row0 + ai * HALF + (m - 1 + odd) * 16) * EH + col0 - 8 * odd) = o; } } }
    }
};
struct EpiDown {
    static constexpr bool PERM = true, HAS_PRE = true;
    const float* bdn; unsigned char* y; const float* slot_gate; const LAS int* tpre; const LAS int* cnt;
    __device__ __forceinline__ const float* pre_src(const Unit& u, int tid) const {
        return tid < 256 ? bdn + (size_t)u.e * DM + u.pn * BM + tid : slot_gate + (size_t)u.e * T + u.pm * BM + tid - 256; }
    __device__ __forceinline__ void run(const f32x4 (&acc)[2][2][4][2], const Unit& u, int wr, int wc, int fr, int fq, const LAS float* tab) const {
        const int lrow0 = u.pm * BM + wr * 64 + fr, row0 = tpre[u.e] * BM + lrow0, col0 = u.pn * BM + wc * 32 + 8 * fq;
        f32x4 bv[2][2];
#pragma unroll
        for (int bj = 0; bj < 2; ++bj)
#pragma unroll
            for (int n = 0; n < 2; ++n) bv[bj][n] = *(const LAS f32x4*)(tab + wc * 32 + 8 * fq + bj * HALF + 4 * n);
        float gts[2][4];
#pragma unroll
        for (int ai = 0; ai < 2; ++ai)
#pragma unroll
            for (int m = 0; m < 4; ++m) { const int r = wr * 64 + fr + ai * HALF + m * 16; const float gv = tab[256 + r]; gts[ai][m] = (u.pm * BM + r < cnt[u.e]) ? gv * Y_MUL : 0.f; }
        const int odd = fq & 1;
#pragma unroll
        for (int ai = 0; ai < 2; ++ai) { u32x2 wm[4][2];
#pragma unroll
            for (int m = 0; m < 4; ++m) { const float gt = gts[ai][m];
#pragma unroll
                for (int bj = 0; bj < 2; ++bj) { const f32x4 v0 = (acc[ai][bj][m][0] * W8_INV + bv[bj][0]) * gt, v1 = (acc[ai][bj][m][1] * W8_INV + bv[bj][1]) * gt;
                    wm[m][bj].x = pack4_fp8(v0[0], v0[1], v0[2], v0[3]); wm[m][bj].y = pack4_fp8(v1[0], v1[1], v1[2], v1[3]);
                    if (m & 1) { const u32x4 o = pair_rows16(wm[m - 1][bj], wm[m][bj]);
                        *(u32x4*)(y + (size_t)(row0 + ai * HALF + (m - 1 + odd) * 16) * DM + col0 - 8 * odd + bj * HALF) = o; } } } }
    }
};
}

struct Args { const float* in[19]; float* out; unsigned char* ws; int ph_lo, ph_hi; };
static_assert(sizeof(Args) == 19 * 8 + 8 + 8 + 8, "Args has no padding");
enum { I_X = 0, I_WIN, I_RELB, I_SLNG, I_SLNB, I_SW, I_SB, I_WBR, I_WOUT, I_LN1G, I_LN1B, I_WR, I_BR, I_WGU, I_BGU, I_WDN, I_BDN, I_LN2G, I_LN2B };

__device__ __forceinline__ unsigned f2bf(float f) { unsigned u = __builtin_bit_cast(unsigned, f); return (u + 0x7fffu + ((u >> 16) & 1u)) >> 16; }
#ifndef CVT_NT
#define CVT_NT 1
#endif
#if CVT_NT
#define CVT_LD(p) __builtin_nontemporal_load(p)
#define CVT_ST(v, p) __builtin_nontemporal_store(v, p)
#else
#define CVT_LD(p) (*(p))
#define CVT_ST(v, p) (*(p) = (v))
#endif
__device__ __forceinline__ unsigned pk4_fp8(float a, float b, float c, float d) { int p = __builtin_amdgcn_cvt_pk_fp8_f32(a, b, 0, false); p = __builtin_amdgcn_cvt_pk_fp8_f32(c, d, p, true); return (unsigned)p; }
struct CvtJob { const float* W; bf16_t* WT; int K, N, perm, ld; };
__device__ __forceinline__ void cvt_load(const CvtJob& j, int it, int lane, f32x4 (&v)[16]) {
    const int nbk = j.N >> 6, per = (j.K >> 6) * nbk; const int mat = it / per, rem = it - mat * per, kb = rem / nbk, nb = rem - kb * nbk;
    const int ld = j.ld ? j.ld : j.N;
    const float* src = j.W + (size_t)mat * j.K * j.N + (size_t)(kb * 64 + 2 * (lane >> 4)) * ld + nb * 64 + 4 * (lane & 15);
#pragma unroll
    for (int i = 0; i < 8; ++i)
#pragma unroll
        for (int b = 0; b < 2; ++b) v[2 * i + b] = CVT_LD((const f32x4*)(src + (size_t)(8 * i + b) * ld));
}
__device__ __forceinline__ void cvt_store(const CvtJob& j, int it, int lane, const f32x4 (&v)[16], LAS unsigned char* scr) {
    const int nbk = j.N >> 6, per = (j.K >> 6) * nbk; const int mat = it / per, rem = it - mat * per, kb = rem / nbk, nb = rem - kb * nbk;
    const int nq = lane & 15, g = lane >> 4;
#pragma unroll
    for (int i = 0; i < 8; ++i)
#pragma unroll
        for (int c = 0; c < 4; ++c) { const int d = 4 * i + g; *(LAS unsigned*)(scr + (4 * nq + c) * 128 + ((d ^ ((nq & 7) << 2)) << 2)) = cvt_pk_bf16(v[2 * i][c], v[2 * i + 1][c]); }
    LDS_WAIT();
    const int n0 = nb * 64; const int drow0 = j.perm ? ((n0 & 2047) >> 7) * 256 + (n0 >> 11) * 128 + (n0 & 127) : n0;
    bf16_t* dst = j.WT + (size_t)mat * j.K * j.N + (size_t)drow0 * j.K + kb * 64;
#pragma unroll
    for (int jj = 0; jj < 8; ++jj) { const int id = lane + 64 * jj, n = id >> 3, kc = id & 7;
        const u32x4 o = *(const LAS u32x4*)(scr + n * 128 + ((kc ^ ((n >> 2) & 7)) << 4));
        CVT_ST(o, (u32x4*)(dst + (size_t)n * j.K + 8 * kc)); }
    LDS_WAIT();
}
template <int K, int N, int LD, int PERM>
__device__ __forceinline__ void cvt8_load(const float* W, int it, int lane, f32x4 (&v)[16]) {
    constexpr int NBK = N / 32, PER = (K / 128) * NBK;
    const int mat = it / PER, rem = it - mat * PER, kb = rem / NBK, nb = rem - kb * NBK;
    const char* ub = (const char*)(W + (size_t)mat * K * N + (size_t)kb * 128 * LD + nb * 32);
    const unsigned loff = (unsigned)((4 * (lane >> 3)) * LD + 4 * (lane & 7)) * 4u;
#pragma unroll
    for (int i = 0; i < 4; ++i)
#pragma unroll
        for (int b = 0; b < 4; ++b) v[4 * i + b] = CVT_LD((const f32x4*)(ub + (size_t)(32 * i + b) * LD * 4 + loff));
}
template <int K, int N, int LD, int PERM>
__device__ __forceinline__ void cvt8_store(unsigned char* WT, int it, int lane, const f32x4 (&v)[16], LAS unsigned char* scr) {
    constexpr int NBK = N / 32, PER = (K / 128) * NBK;
    const int mat = it / PER, rem = it - mat * PER, kb = rem / NBK, nb = rem - kb * NBK;
    const int nq = lane & 7, gk = lane >> 3;
    LAS unsigned char* wp = scr + (4 * nq) * 128 + (gk << 2);
#pragma unroll
    for (int i = 0; i < 4; ++i) { const f32x4 s0 = v[4 * i] * pg8::W8_MUL, s1 = v[4 * i + 1] * pg8::W8_MUL, s2 = v[4 * i + 2] * pg8::W8_MUL, s3 = v[4 * i + 3] * pg8::W8_MUL;
        const int xo = ((i ^ (nq & 3)) << 5);
#pragma unroll
        for (int c = 0; c < 4; ++c) *(LAS unsigned*)(wp + c * 128 + xo) = pk4_fp8(s0[c], s1[c], s2[c], s3[c]); }
    LDS_WAIT();
    const int n0 = nb * 32; const int drow0 = PERM ? ((n0 & 2047) >> 7) * 256 + (n0 >> 11) * 128 + (n0 & 127) : n0;
    unsigned char* ub = WT + (size_t)mat * K * N + (size_t)drow0 * K + kb * 128;
    const unsigned soff = (unsigned)((lane >> 3) * K + 16 * (lane & 7));
    const int kc = lane & 7;
#pragma unroll
    for (int jj = 0; jj < 4; ++jj) { const int n = (lane >> 3) + 8 * jj;
        const u32x4 o = *(const LAS u32x4*)(scr + n * 128 + ((kc ^ (((n >> 2) & 3) << 1)) << 4));
        CVT_ST(o, (u32x4*)(ub + (size_t)jj * 8 * K + soff)); }
    LDS_WAIT();
}
template <int K, int N, int LD, int PERM>
__device__ __forceinline__ void cvt8_run(const float* W, unsigned char* WT, int ntiles_, int gw, int nw, int lane_, LAS unsigned char* scr, int rep = 1) {
    int lane = lane_; asm volatile("" : "+v"(lane)); const int ntiles = ntiles_ * rep;
    f32x4 va[16], vb[16];
    int it = gw;
    if (it < ntiles) cvt8_load<K, N, LD, PERM>(W, it % ntiles_, lane, va);
    while (it < ntiles) {
        const int it1 = it + nw;
        if (it1 < ntiles) cvt8_load<K, N, LD, PERM>(W, it1 % ntiles_, lane, vb);
        cvt8_store<K, N, LD, PERM>(WT, it % ntiles_, lane, va, scr);
        if (it1 >= ntiles) break;
        const int it2 = it1 + nw;
        if (it2 < ntiles) cvt8_load<K, N, LD, PERM>(W, it2 % ntiles_, lane, va);
        cvt8_store<K, N, LD, PERM>(WT, it1 % ntiles_, lane, vb, scr);
        it = it2;
    }
}
template <int K, int N, int LD, int PERM>
__device__ __forceinline__ void cvt8s_load(const float* W, int st, int wave, int lane, f32x4 (&v)[16]) {
    constexpr int NBK = N / 256, PER = (K / 128) * NBK;
    const int mat = st / PER, rem = st - mat * PER, kb = rem / NBK, nb = rem - kb * NBK;
    const char* ub = (const char*)(W + (size_t)mat * K * N + (size_t)(kb * 128 + 16 * wave) * LD + nb * 256);
#pragma unroll
    for (int j = 0; j < 16; ++j) v[j] = CVT_LD((const f32x4*)(ub + (size_t)j * LD * 4 + lane * 16));
}
template <int K, int N, int LD, int PERM>
__device__ __forceinline__ void cvt8s_store(unsigned char* WT, int st, int tid, int wave, int lane, const f32x4 (&v)[16], LAS unsigned char* img) {
    constexpr int NBK = N / 256, PER = (K / 128) * NBK;
    const int mat = st / PER, rem = st - mat * PER, kb = rem / NBK, nb = rem - kb * NBK;
    LAS unsigned char* wp = img + (4 * lane) * 144 + 16 * (wave ^ ((lane >> 2) & 7));
#pragma unroll
    for (int c = 0; c < 4; ++c) { u32x4 o;
        o.x = pk4_fp8(v[0][c] * pg8::W8_MUL, v[1][c] * pg8::W8_MUL, v[2][c] * pg8::W8_MUL, v[3][c] * pg8::W8_MUL); o.y = pk4_fp8(v[4][c] * pg8::W8_MUL, v[5][c] * pg8::W8_MUL, v[6][c] * pg8::W8_MUL, v[7][c] * pg8::W8_MUL);
        o.z = pk4_fp8(v[8][c] * pg8::W8_MUL, v[9][c] * pg8::W8_MUL, v[10][c] * pg8::W8_MUL, v[11][c] * pg8::W8_MUL); o.w = pk4_fp8(v[12][c] * pg8::W8_MUL, v[13][c] * pg8::W8_MUL, v[14][c] * pg8::W8_MUL, v[15][c] * pg8::W8_MUL);
        *(LAS u32x4*)(wp + c * 144) = o; }
    __syncthreads();
    unsigned char* ub = WT + (size_t)mat * K * N + kb * 128;
#pragma unroll
    for (int jj = 0; jj < 4; ++jj) { const int id = tid + 512 * jj, n = id >> 3, pc = id & 7, kc = pc ^ ((n >> 4) & 7);
        const int ng = nb * 256 + n; const int drow = PERM ? ((ng & 2047) >> 7) * 256 + (ng >> 11) * 128 + (ng & 127) : ng;
        const u32x4 o = *(const LAS u32x4*)(img + n * 144 + 16 * pc);
        CVT_ST(o, (u32x4*)(ub + (size_t)drow * K + 16 * kc)); }
}
template <int K, int N, int LD, int PERM>
__device__ __forceinline__ void cvt8s_run(const float* W, unsigned char* WT, int nst_, int first, int step, int tid_, int wave, LAS unsigned char* img, int rep = 1) {
    int tid = tid_; asm volatile("" : "+v"(tid)); const int lane = tid & 63; const int nst = nst_ * rep;
    f32x4 va[16], vb[16];
    int st = first;
    if (st < nst) cvt8s_load<K, N, LD, PERM>(W, st % nst_, wave, lane, va);
    while (st < nst) {
        const int s1 = st + step;
        if (s1 < nst) cvt8s_load<K, N, LD, PERM>(W, s1 % nst_, wave, lane, vb);
        cvt8s_store<K, N, LD, PERM>(WT, st % nst_, tid, wave, lane, va, img);
        if (s1 >= nst) break;
        const int s2 = s1 + step;
        if (s2 < nst) cvt8s_load<K, N, LD, PERM>(W, s2 % nst_, wave, lane, va);
        cvt8s_store<K, N, LD, PERM>(WT, s1 % nst_, tid, wave, lane, vb, img + 36864);
        st = s2;
    }
    __syncthreads();
}
__device__ __forceinline__ void cvt_run(const CvtJob& j, int ntiles, int gw, int nw, int lane, LAS unsigned char* scr) {
    f32x4 va[16], vb[16];
    int it = gw;
    if (it < ntiles) cvt_load(j, it, lane, va);
    while (it < ntiles) {
        const int it1 = it + nw;
        if (it1 < ntiles) cvt_load(j, it1, lane, vb);
        cvt_store(j, it, lane, va, scr);
        if (it1 >= ntiles) break;
        const int it2 = it1 + nw;
        if (it2 < ntiles) cvt_load(j, it2, lane, va);
        cvt_store(j, it1, lane, vb, scr);
        it = it2;
    }
}

__device__ __forceinline__ unsigned pack4_i8(float a, float b, float c, float d) {
    const int ia = (int)__builtin_rintf(a), ib = (int)__builtin_rintf(b), ic = (int)__builtin_rintf(c), id = (int)__builtin_rintf(d);
    return (unsigned)(ia & 0xff) | ((unsigned)(ib & 0xff) << 8) | ((unsigned)(ic & 0xff) << 16) | ((unsigned)id << 24);
}
__device__ __forceinline__ void x_to_i8(const float* x, unsigned* xq, float* xs, int gw, int ngw, int lane) {
    for (int t = gw; t < T; t += ngw) {
        f32x4 v[8]; float am = 0.f;
#pragma unroll
        for (int i = 0; i < 8; ++i) { v[i] = *(const f32x4*)(x + (size_t)t * DM + 4 * lane + 256 * i); am = fmaxf(am, fmaxf(fmaxf(fabsf(v[i][0]), fabsf(v[i][1])), fmaxf(fabsf(v[i][2]), fabsf(v[i][3])))); }
        am = wave_max(am); const float inv = am > 0.f ? 127.0f / am : 0.f;
#pragma unroll
        for (int i = 0; i < 8; ++i) xq[((size_t)t * DM + 4 * lane + 256 * i) >> 2] = pack4_i8(v[i][0] * inv, v[i][1] * inv, v[i][2] * inv, v[i][3] * inv);
        if (lane == 0) xs[t] = am * (1.0f / 127.0f);
    }
}
template <int LD>
__device__ __forceinline__ void cvt_i8_strips(const float* W, unsigned char* Wq, float* cscale, int nstrips, int first, int step, int tid_, LAS unsigned char* lds) {
    int tid = tid_; asm volatile("" : "+v"(tid));
    LAS float* red = (LAS float*)lds; LAS unsigned char* img = lds + 8192; LAS float* sinv = (LAS float*)(lds + 8192 + 65536);
    const int c4 = tid & 7, kq = tid >> 3;
    for (int st = first; st < nstrips; st += step) {
        const int n0 = 32 * st;
        f32x4 v[8][4];
        const float* src = W + (size_t)(4 * kq) * LD + n0 + 4 * c4;
#pragma unroll
        for (int i = 0; i < 8; ++i)
#pragma unroll
            for (int j = 0; j < 4; ++j) v[i][j] = CVT_LD((const f32x4*)(src + (size_t)(256 * i + j) * LD));
        f32x4 m = (f32x4){0.f, 0.f, 0.f, 0.f};
#pragma unroll
        for (int i = 0; i < 8; ++i)
#pragma unroll
            for (int j = 0; j < 4; ++j) m = __builtin_elementwise_max(m, __builtin_elementwise_abs(v[i][j]));
        *(LAS f32x4*)(red + kq * 32 + 4 * c4) = m;
        __syncthreads();
        if (tid < 32) { float mx = 0.f;
#pragma unroll 8
            for (int r = 0; r < 64; ++r) mx = fmaxf(mx, red[r * 32 + tid]);
            cscale[n0 + tid] = mx * (1.0f / 127.0f); sinv[tid] = mx > 0.f ? 127.0f / mx : 0.f; }
        __syncthreads();
        const f32x4 iv = *(const LAS f32x4*)(sinv + 4 * c4);
#pragma unroll
        for (int i = 0; i < 8; ++i)
#pragma unroll
            for (int c = 0; c < 4; ++c) { const int d = kq + 64 * i;
                *(LAS unsigned*)(img + (4 * c4 + c) * 2048 + ((d ^ (c4 << 3)) << 2)) = pack4_i8(v[i][0][c] * iv[c], v[i][1][c] * iv[c], v[i][2][c] * iv[c], v[i][3][c] * iv[c]); }
        __syncthreads();
#pragma unroll
        for (int jj = 0; jj < 8; ++jj) { const int id = tid + 512 * jj, n = id >> 7, q = id & 127;
            const u32x4 o = *(const LAS u32x4*)(img + n * 2048 + ((q ^ ((n >> 2) << 1)) << 4));
            CVT_ST(o, (u32x4*)(Wq + (size_t)(n0 + n) * 2048 + 16 * q)); }
        __syncthreads();
    }
}

__device__ __forceinline__ void p0_prologue(const Args& a, LAS unsigned char* lds, int vcu, int G, int wave, int lane) {
    unsigned char* ws = a.ws;
    LAS unsigned char* scr = lds + wave * 8192;
    const int gw = vcu * NWAVES + wave, NGW = G * NWAVES;
#if P1_I8
    cvt_i8_strips<INC>(a.in[I_WIN], ws + WS_WIN, (float*)(ws + WS_WCS), INC / 32, vcu, G, (int)threadIdx.x, lds);
    x_to_i8(a.in[I_X], (unsigned*)(ws + WS_XB), (float*)(ws + WS_XS), gw, NGW, lane);
#elif P1_FP8
    cvt8s_run<DM, INC, INC, 0>(a.in[I_WIN], ws + WS_WIN, (DM / 128) * (INC / 256), vcu, G, (int)threadIdx.x, wave, lds);
#else
    { CvtJob j{a.in[I_WIN], (bf16_t*)(ws + WS_WIN), DM, INC, 0, 0}; cvt_run(j, (DM / 64) * (INC / 64), gw, NGW, lane, scr); }
#endif
#if CONV1_WGS == 0
    { CvtJob j{a.in[I_WGU], (bf16_t*)(ws + WS_WGU), DM, 2 * EH, 1, 0}; cvt_run(j, NE * (DM / 64) * (2 * EH / 64), gw, NGW, lane, scr); }
#endif
#if CONV2_WGS == 0
    { CvtJob j{a.in[I_WDN], (bf16_t*)(ws + WS_WDN), EH, DM, 0, 0}; cvt_run(j, NE * (EH / 64) * (DM / 64), gw, NGW, lane, scr); }
#endif
    if (vcu == 0) {
        LAS float* pred = (LAS float*)(lds + 65536); const int tid = threadIdx.x, e = tid & 31, part = tid >> 5; float pcg = 0.f, pcb = 0.f;
        const float* Wr = a.in[I_WR]; const float* g1 = a.in[I_LN1G]; const float* b1 = a.in[I_LN1B];
        for (int jj = 0; jj < 128; ++jj) { const int k = part * 128 + jj; const float w = Wr[(size_t)k * NE + e]; pcg += g1[k] * w; pcb += b1[k] * w; }
        pred[part * 32 + e] = pcg; pred[512 + part * 32 + e] = pcb;
        __syncthreads();
        if (tid < 32) { float sg = 0.f, sb_ = a.in[I_BR][tid];
            for (int pp = 0; pp < 16; ++pp) { sg += pred[pp * 32 + tid]; sb_ += pred[512 + pp * 32 + tid]; }
            ((float*)(ws + WS_CGB))[tid] = sg; ((float*)(ws + WS_CGB))[32 + tid] = sb_; }
    }
    const f32x4* x4 = (const f32x4*)a.in[I_X]; u32x2* xb = (u32x2*)(ws + WS_XB);
    const size_t n4 = (size_t)T * DM / 4, stride = (size_t)G * NTHR;
#if P1_I8
    (void)x4; (void)xb; (void)n4; (void)stride; (void)scr;
#elif P1_FP8
    unsigned* xq = (unsigned*)(ws + WS_XB); u32x2* xb2 = (u32x2*)(ws + WS_H + 64 * MiB);
    for (size_t i = (size_t)vcu * NTHR + threadIdx.x; i < n4; i += stride) { const f32x4 v = x4[i]; xq[i] = pk4_fp8(v[0], v[1], v[2], v[3]);
        u32x2 o; o.x = cvt_pk_bf16(v[0], v[1]); o.y = cvt_pk_bf16(v[2], v[3]); xb2[i] = o; }
    { CvtJob j{a.in[I_WIN] + O_Z, (bf16_t*)(ws + WS_WIN + 32 * MiB), DM, BW, 0, INC}; cvt_run(j, (DM / 64) * (BW / 64), gw, NGW, lane, scr); }
#else
    for (size_t i = (size_t)vcu * NTHR + threadIdx.x; i < n4; i += stride) { const f32x4 v = x4[i]; u32x2 o; o.x = cvt_pk_bf16(v[0], v[1]); o.y = cvt_pk_bf16(v[2], v[3]); xb[i] = o; }
#endif
    {
        bf16_t* wg3 = (bf16_t*)(ws + WS_WG3); const float* Wr = a.in[I_WR]; const float* g1 = a.in[I_LN1G];
        for (int idx = vcu * NTHR + (int)threadIdx.x; idx < NE * DM / 8; idx += G * NTHR) { const int e = idx / (DM / 8), k0 = (idx - e * (DM / 8)) * 8;
            float w[8]; u32x4 hi, mid, lo;
#pragma unroll
            for (int j = 0; j < 8; ++j) w[j] = Wr[(size_t)(k0 + j) * NE + e] * g1[k0 + j];
#pragma unroll
            for (int j = 0; j < 4; ++j) { const unsigned h = cvt_pk_bf16(w[2 * j], w[2 * j + 1]); const float r0 = w[2 * j] - bf_lo(h), r1_ = w[2 * j + 1] - bf_hi(h);
                const unsigned m = cvt_pk_bf16(r0, r1_); const unsigned l = cvt_pk_bf16(r0 - bf_lo(m), r1_ - bf_hi(m)); hi[j] = h; mid[j] = m; lo[j] = l; }
            *(u32x4*)(wg3 + (size_t)e * DM + k0) = hi; *(u32x4*)(wg3 + (size_t)(NE + e) * DM + k0) = mid; *(u32x4*)(wg3 + (size_t)(2 * NE + e) * DM + k0) = lo; } }
}

__device__ __forceinline__ int kimg8(int row, int c16) { return row * 128 + 16 * (c16 ^ (((row >> 1) & 1) | (((row >> 3) & 1) << 2))); }
struct AttnU { int b, g, h, c, n, r; };
__device__ __forceinline__ AttnU attn_decode(int unit) {
    AttnU U; const int v = unit % 3072, w = v / 12, k = v - 12 * w, j = k & 3, q = w & 3; U.g = k >> 2; U.b = w >> 5; U.h = (w >> 2) & 7;
    const int cn = 4 * q + j, lr = 2 * U.g; U.r = 1 << lr; U.c = cn >> (4 - lr); U.n = cn & ((16 >> lr) - 1); return U;
}
constexpr int ABIAS_STR = 212, ABIAS_NINF = 164;
__device__ __forceinline__ void attn_issue(const bf16_t* QKV, const float* rel_bias, const AttnU& U, bool need_prev, int tid, int wave, int lane, u32x4 (&kv)[4], u32x4 (&vv)[4], u32x4 (&Qf)[2], float (&bval)[2]) {
#pragma unroll
    for (int q = 0; q < 2; ++q) {
        const int e = tid + 512 * q, sc = e / ABIAS_STR, k = e - sc * ABIAS_STR, sub = 160 - (k + sc); const bool valid = sub >= 0 && sub <= 128;
        const int dist = U.r * (valid ? sub : 0); int bucket = dist;
        if (dist >= 16) { bucket = 16 + (int)(logf((float)dist * 0.0625f) / 4.852030263919617f * 16.0f); bucket = bucket > 31 ? 31 : bucket; }
        bval[q] = rel_bias[bucket * 24 + U.g * 8 + U.h]; }
    constexpr size_t WH = (size_t)3 * 8 * 8 * 2048 * 128;
    const int L = 2048 / U.r;
    const bf16_t* Qb = QKV + (((size_t)(U.g * 8 + U.h) * 8 + U.b) * 2048 + (size_t)U.c * L) * 128;
    const size_t seq8 = (((size_t)(U.g * 8 + U.h) * 8 + U.b) * 2048 + (size_t)U.c * L) * 128;
    const unsigned char* Kb = (const unsigned char*)(QKV + WH) + seq8; const unsigned char* Vb = (const unsigned char*)(QKV + 2 * WH) + seq8;
#pragma unroll
    for (int i = 0; i < 4; ++i) { const int id = tid + 512 * (i & 1), row = id >> 3, c16 = id & 7; const int m = (U.n - 1) * 128 + (i >> 1) * 128 + row;
        if (i >= 2 || need_prev) { kv[i] = *(const u32x4*)(Kb + (size_t)m * 128 + c16 * 16); vv[i] = *(const u32x4*)(Vb + (size_t)m * 128 + c16 * 16); }
        else { kv[i] = (u32x4){0u, 0u, 0u, 0u}; vv[i] = (u32x4){0u, 0u, 0u, 0u}; } }
    const int mq = U.n * 128 + 16 * wave + (lane & 15);
    const unsigned char* Q8 = (const unsigned char*)QKV + seq8 + (size_t)mq * 128 + 32 * (lane >> 4);
    Qf[0] = *(const u32x4*)Q8; Qf[1] = *(const u32x4*)(Q8 + 16);
}
__device__ __forceinline__ void attn_phase(LAS unsigned char* lds, const bf16_t* P, bf16_t* og, float* lse, const float* rel_bias, int wg, int nwg, int nunits, int tid, int wave, int lane) {
    LAS unsigned char* Kimg = lds; LAS unsigned char* Vimg = lds + 65536; LAS float* biasC = (LAS float*)(lds + TOKTAB_OFF);
    const int upw = (nunits + nwg - 1) / nwg, u0 = wg * upw, u1 = (u0 + upw < nunits) ? u0 + upw : nunits;
    if (u0 >= u1) return;
    u32x4 kv[4], vv[4]; pg8::i32x8 Qf8; u32x4 Qn[2];
    AttnU U = attn_decode(u0);
    float bval[2];
    bool need_prev = U.n > 0; int flip = 0;
    attn_issue(P, rel_bias, U, need_prev, tid, wave, lane, kv, vv, Qn, bval);
    const int qi = lane & 15, gq = lane >> 4, q4 = qi >> 2, p4 = qi & 3;
    for (int unit = u0; unit < u1; ++unit) {
        const int fx = flip << 15; const int flip_c = flip;
#pragma unroll
        for (int i = 0; i < 4; ++i) { const int id = tid + 512 * (i & 1), row = (i >> 1) * 128 + (id >> 3), c16 = id & 7;
            if (i < 2 && !need_prev) continue;
            const int o0 = (int)off_b(row, 2 * c16) + (i < 2 ? fx : -fx), o1 = (int)off_b(row, 2 * c16 + 1) + (i < 2 ? fx : -fx);
            *(LAS u32x4*)(Kimg + kimg8(row, c16) + (i < 2 ? (flip << 14) : -(flip << 14))) = kv[i];
#pragma unroll
            for (int kvsel = 1; kvsel < 2; ++kvsel) { const u32x4 w = kvsel ? vv[i] : kv[i]; u32x4 lo, hi;
                { f32x2 a = __builtin_amdgcn_cvt_pk_f32_fp8((int)w.x, false), b = __builtin_amdgcn_cvt_pk_f32_fp8((int)w.x, true); lo.x = cvt_pk_bf16(a[0], a[1]); lo.y = cvt_pk_bf16(b[0], b[1]); }
                { f32x2 a = __builtin_amdgcn_cvt_pk_f32_fp8((int)w.y, false), b = __builtin_amdgcn_cvt_pk_f32_fp8((int)w.y, true); lo.z = cvt_pk_bf16(a[0], a[1]); lo.w = cvt_pk_bf16(b[0], b[1]); }
                { f32x2 a = __builtin_amdgcn_cvt_pk_f32_fp8((int)w.z, false), b = __builtin_amdgcn_cvt_pk_f32_fp8((int)w.z, true); hi.x = cvt_pk_bf16(a[0], a[1]); hi.y = cvt_pk_bf16(b[0], b[1]); }
                { f32x2 a = __builtin_amdgcn_cvt_pk_f32_fp8((int)w.w, false), b = __builtin_amdgcn_cvt_pk_f32_fp8((int)w.w, true); hi.z = cvt_pk_bf16(a[0], a[1]); hi.w = cvt_pk_bf16(b[0], b[1]); }
                LAS unsigned char* img = kvsel ? Vimg : Kimg;
                *(LAS u32x4*)(img + o0) = lo; *(LAS u32x4*)(img + o1) = hi; } }
#pragma unroll
        for (int q = 0; q < 2; ++q) { const int e = tid + 512 * q, sc = e / ABIAS_STR, k = e - sc * ABIAS_STR, sub = 160 - (k + sc);
            if (e < 4 * ABIAS_STR) biasC[e] = (sub >= 0 && sub <= 128) ? bval[q] * 1.4426950408889634f : -INFINITY; }
        Qf8 = __builtin_shufflevector(__builtin_bit_cast(pg8::i32x4, Qn[0]), __builtin_bit_cast(pg8::i32x4, Qn[1]), 0, 1, 2, 3, 4, 5, 6, 7);
        const AttnU Uc = U;
        __syncthreads();
        int flip_next = flip;
        if (unit + 1 < u1) { U = attn_decode(unit + 1);
            const bool reuse = U.b == Uc.b && U.g == Uc.g && U.h == Uc.h && U.c == Uc.c && U.n == Uc.n + 1;
            need_prev = U.n > 0 && !reuse; flip_next = reuse ? flip ^ 1 : flip;
            attn_issue(P, rel_bias, U, need_prev, tid, wave, lane, kv, vv, Qn, bval); }
        const int n = Uc.n;
        const int qrow = 16 * wave + qi;
        const size_t qtok = (size_t)((n * 128 + qrow) * Uc.r + Uc.c);
        const int kt0 = 2 * (wave >> 1);
        const int kperm = 8 * ((qi >> 2) & 1) + 4 * (qi >> 3) + (qi & 3), gperm = 8 * (gq & 1) + 4 * (gq >> 1);
        const int nskip = (n == 0) ? 8 - kt0 : 0;
        f32x4 S[10];
#pragma unroll
        for (int i = 0; i < 10; ++i) { S[i] = (f32x4){0.f, 0.f, 0.f, 0.f};
            if (i < nskip) continue;
            const LAS unsigned char* Kt = Kimg + (kt0 + i < 8 ? (flip_c << 14) : -(flip_c << 14));
            const int krow = 16 * (kt0 + i) + kperm;
            const pg8::i32x8 k8 = __builtin_shufflevector(*(const LAS pg8::i32x4*)(Kt + kimg8(krow, 2 * gq)), *(const LAS pg8::i32x4*)(Kt + kimg8(krow, 2 * gq + 1)), 0, 1, 2, 3, 4, 5, 6, 7);
            asm("s_nop 1\n\tv_mfma_f32_16x16x128_f8f6f4 %0, %1, %2, %0" : "+v"(S[i]) : "v"(k8), "v"(Qf8)); }
        asm volatile("s_nop 15\n\ts_nop 15" ::: "memory");
        const int sl = (-qi) & 3;
        const LAS float* brow = biasC + sl * ABIAS_STR + (16 * kt0 + gperm - qrow + 32 - sl);
        const LAS float* bninf = biasC + sl * ABIAS_STR + ABIAS_NINF;
        float mx = -INFINITY;
#pragma unroll
        for (int i = 0; i < 10; ++i) { const f32x4 bb = *(const LAS f32x4*)(i < nskip ? bninf : brow + 16 * i);
#pragma unroll
            for (int j = 0; j < 4; ++j) { S[i][j] = __builtin_fmaf(S[i][j], 0.08838834764831845f * 1.4426950408889634f / (pg8::V8_MUL * pg8::V8_MUL), bb[j]); mx = fmaxf(mx, S[i][j]); } }
        mx = fmaxf(mx, __shfl_xor(mx, 16)); mx = fmaxf(mx, __shfl_xor(mx, 32));
        float sum = 0.f;
#pragma unroll
        for (int i = 0; i < 10; ++i)
#pragma unroll
            for (int j = 0; j < 4; ++j) { const float p = __builtin_amdgcn_exp2f(S[i][j] - mx); S[i][j] = p; sum += p; }
        sum += __shfl_xor(sum, 16); sum += __shfl_xor(sum, 32);
        f32x4 O[8];
#pragma unroll
        for (int cc = 0; cc < 8; ++cc) O[cc] = (f32x4){0.f, 0.f, 0.f, 0.f};
#pragma unroll
        for (int ks = 0; ks < 5; ++ks) {
            if (2 * ks + 1 < nskip) continue;
            const LAS unsigned char* Vt = Vimg + (kt0 + 2 * ks < 8 ? fx : -fx);
            u32x4 pw; pw.x = cvt_pk_bf16(S[2 * ks][0], S[2 * ks][1]); pw.y = cvt_pk_bf16(S[2 * ks][2], S[2 * ks][3]);
            pw.z = cvt_pk_bf16(S[2 * ks + 1][0], S[2 * ks + 1][1]); pw.w = cvt_pk_bf16(S[2 * ks + 1][2], S[2 * ks + 1][3]);
            const bf16x8 pb = __builtin_bit_cast(bf16x8, pw);
            const int rbase = 16 * kt0 + 32 * ks + gperm + q4;
#pragma unroll
            for (int cc = 0; cc < 8; ++cc) {
                const s16x4 v0 = __builtin_amdgcn_ds_read_tr16_b64_v4i16((LAS s16x4*)(Vt + off_b(rbase, 2 * cc + (p4 >> 1)) + 8 * (p4 & 1)));
                const s16x4 v1 = __builtin_amdgcn_ds_read_tr16_b64_v4i16((LAS s16x4*)(Vt + off_b(rbase + 16, 2 * cc + (p4 >> 1)) + 8 * (p4 & 1)));
                bf16x8 vf; vf[0] = v0[0]; vf[1] = v0[1]; vf[2] = v0[2]; vf[3] = v0[3]; vf[4] = v1[0]; vf[5] = v1[1]; vf[6] = v1[2]; vf[7] = v1[3];
                O[cc] = __builtin_amdgcn_mfma_f32_16x16x32_bf16(vf, pb, O[cc], 0, 0, 0); }
        }
        const float inv = __builtin_amdgcn_rcpf(sum);
        const size_t tok = (size_t)Uc.b * SEQ + qtok;
        unsigned char* orow = (unsigned char*)og + ((size_t)Uc.g * T + tok) * BW + Uc.h * 128 + 4 * gq;
        const float inv16 = inv * (pg8::YA_MUL / pg8::V8_MUL);
        {
            unsigned o8[8];
#pragma unroll
            for (int cc = 0; cc < 8; ++cc) o8[cc] = pk4_fp8(O[cc][0] * inv16, O[cc][1] * inv16, O[cc][2] * inv16, O[cc][3] * inv16);
            unsigned char* obase = orow - 4 * gq;
#pragma unroll
            for (int c4 = 0; c4 < 2; ++c4) { unsigned r0 = o8[4 * c4], r1 = o8[4 * c4 + 1], r2 = o8[4 * c4 + 2], r3 = o8[4 * c4 + 3];
                { auto a = __builtin_amdgcn_permlane16_swap(r0, r1, false, false); r0 = a[0]; r1 = a[1]; auto b = __builtin_amdgcn_permlane16_swap(r2, r3, false, false); r2 = b[0]; r3 = b[1]; }
                { auto a = __builtin_amdgcn_permlane32_swap(r0, r2, false, false); r0 = a[0]; r2 = a[1]; auto b = __builtin_amdgcn_permlane32_swap(r1, r3, false, false); r1 = b[0]; r3 = b[1]; }
                u32x4 ov; ov.x = r0; ov.y = r1; ov.z = r2; ov.w = r3;
                *(u32x4*)(obase + 16 * (4 * c4 + gq)) = ov; } }
        if (gq == 0) lse[((size_t)Uc.g * T + tok) * 8 + Uc.h] = (mx + __builtin_amdgcn_logf(sum)) * 0.6931471805599453f;
        __syncthreads();
        flip = flip_next;
    }
}

__device__ __forceinline__ void sgu_load_group(const Args& a, const bf16_t* P, size_t t0, int gg, int tid, f32x4 (&wreg)[4][2], u32x4 (&vreg)[4]) {
    const float* sw = a.in[I_SW];
#pragma unroll
    for (int k = 0; k < 4; ++k) { const int id = tid + 512 * k, i = id >> 4, ch = id & 15;
        const float* wp = sw + ((size_t)gg * 128 + i) * 128 + ch * 8; wreg[k][0] = *(const f32x4*)wp; wreg[k][1] = *(const f32x4*)(wp + 4);
        vreg[k] = *(const u32x4*)(P + (t0 + i) * INC + O_Z + BW + gg * 128 + ch * 8); }
}
__device__ __forceinline__ void sgu_unit(LAS unsigned char* lds, const Args& a, const bf16_t* P, bf16_t* ys, int unit, int tid, int wave, int lane) {
    const int gh = unit & 1, bc = unit >> 1;
    const size_t t0 = (size_t)bc * 128;
    LAS unsigned char* Wimg = lds; LAS unsigned char* Vimg = lds + 32768; LAS float* mu = (LAS float*)(lds + 65536); LAS float* rs = mu + 128;
    LAS float* lgl = (LAS float*)(lds + 65536 + 1024); LAS float* lbl = lgl + 1024;
    const float* sb = a.in[I_SB];
    f32x4 wreg[4][2]; u32x4 vreg[4];
    sgu_load_group(a, P, t0, gh * 4, tid, wreg, vreg);
    for (int i = tid; i < BW; i += NTHR) { lgl[i] = a.in[I_SLNG][i]; lbl[i] = a.in[I_SLNB][i]; }
    {
        const int row = tid >> 2, part = tid & 3; const bf16_t* src = P + (t0 + row) * INC + O_Z + BW + part * 8;
        float s = 0.f, q = 0.f;
#pragma unroll 8
        for (int i = 0; i < 32; ++i) { const u32x4 w = *(const u32x4*)(src + i * 32);
            const float v0 = bf_lo(w.x), v1 = bf_hi(w.x), v2 = bf_lo(w.y), v3 = bf_hi(w.y), v4 = bf_lo(w.z), v5 = bf_hi(w.z), v6 = bf_lo(w.w), v7 = bf_hi(w.w);
            s += ((v0 + v1) + (v2 + v3)) + ((v4 + v5) + (v6 + v7)); q += ((v0 * v0 + v1 * v1) + (v2 * v2 + v3 * v3)) + ((v4 * v4 + v5 * v5) + (v6 * v6 + v7 * v7)); }
        s += __shfl_xor(s, 1); s += __shfl_xor(s, 2); q += __shfl_xor(q, 1); q += __shfl_xor(q, 2);
        const float mean = s * (1.0f / 1024.0f); const float var = fmaxf(q * (1.0f / 1024.0f) - mean * mean, 0.f);
        if (part == 0) { mu[row] = mean; rs[row] = 1.0f / sqrtf(var + LN_EPS); } }
    __syncthreads();
    const int li = lane & 15, gq = lane >> 4, q4 = li >> 2, p4 = li & 3;
    for (int gi = 0; gi < 4; ++gi) { const int gg = gh * 4 + gi;
#pragma unroll
        for (int k = 0; k < 4; ++k) { const int id = tid + 512 * k, i = id >> 4, ch = id & 15;
            float w[8] = {wreg[k][0][0], wreg[k][0][1], wreg[k][0][2], wreg[k][0][3], wreg[k][1][0], wreg[k][1][1], wreg[k][1][2], wreg[k][1][3]};
#pragma unroll
            for (int j = 0; j < 8; ++j) if (ch * 8 + j > i) w[j] = 0.f;
            u32x4 o; o.x = cvt_pk_bf16(w[0], w[1]); o.y = cvt_pk_bf16(w[2], w[3]); o.z = cvt_pk_bf16(w[4], w[5]); o.w = cvt_pk_bf16(w[6], w[7]);
            *(LAS u32x4*)(Wimg + off_b(i, ch)) = o;
            const int chn = gg * 128 + ch * 8; const u32x4 vw = vreg[k];
            const f32x4 g0 = *(const LAS f32x4*)(lgl + chn), g1 = *(const LAS f32x4*)(lgl + chn + 4), b0 = *(const LAS f32x4*)(lbl + chn), b1 = *(const LAS f32x4*)(lbl + chn + 4);
            const float m_ = mu[i], r_ = rs[i];
            float v[8] = {bf_lo(vw.x), bf_hi(vw.x), bf_lo(vw.y), bf_hi(vw.y), bf_lo(vw.z), bf_hi(vw.z), bf_lo(vw.w), bf_hi(vw.w)};
            v[0] = (v[0] - m_) * r_ * g0[0] + b0[0]; v[1] = (v[1] - m_) * r_ * g0[1] + b0[1]; v[2] = (v[2] - m_) * r_ * g0[2] + b0[2]; v[3] = (v[3] - m_) * r_ * g0[3] + b0[3];
            v[4] = (v[4] - m_) * r_ * g1[0] + b1[0]; v[5] = (v[5] - m_) * r_ * g1[1] + b1[1]; v[6] = (v[6] - m_) * r_ * g1[2] + b1[2]; v[7] = (v[7] - m_) * r_ * g1[3] + b1[3];
            u32x4 ov; ov.x = cvt_pk_bf16(v[0], v[1]); ov.y = cvt_pk_bf16(v[2], v[3]); ov.z = cvt_pk_bf16(v[4], v[5]); ov.w = cvt_pk_bf16(v[6], v[7]);
            *(LAS u32x4*)(Vimg + off_b(i, ch)) = ov; }
        __syncthreads();
        if (gi < 3) sgu_load_group(a, P, t0, gg + 1, tid, wreg, vreg);
        const int itok = 16 * wave + li; const float bs = sb[gg * 128 + itok];
        const bf16_t* up = P + (t0 + itok) * INC + O_Z + gg * 128 + 4 * gq;
        u32x2 uu[8];
#pragma unroll
        for (int cc = 0; cc < 8; ++cc) uu[cc] = *(const u32x2*)(up + 16 * cc);
        bf16x8 Af[4];
#pragma unroll
        for (int s = 0; s < 4; ++s) Af[s] = *(const LAS bf16x8*)(Wimg + off_b(16 * wave + li, 4 * s + gq));
        bf16_t* yp = ys + (t0 + itok) * BW + gg * 128 + 4 * gq; unsigned y8[8];
#pragma unroll
        for (int cc = 0; cc < 8; ++cc) { f32x4 C = (f32x4){0.f, 0.f, 0.f, 0.f};
#pragma unroll
            for (int s = 0; s < 4; ++s) { const int rbase = 32 * s + 8 * gq + q4;
                const s16x4 v0 = __builtin_amdgcn_ds_read_tr16_b64_v4i16((LAS s16x4*)(Vimg + off_b(rbase, 2 * cc + (p4 >> 1)) + 8 * (p4 & 1)));
                const s16x4 v1 = __builtin_amdgcn_ds_read_tr16_b64_v4i16((LAS s16x4*)(Vimg + off_b(rbase + 4, 2 * cc + (p4 >> 1)) + 8 * (p4 & 1)));
                bf16x8 vf; vf[0] = v0[0]; vf[1] = v0[1]; vf[2] = v0[2]; vf[3] = v0[3]; vf[4] = v1[0]; vf[5] = v1[1]; vf[6] = v1[2]; vf[7] = v1[3];
                C = __builtin_amdgcn_mfma_f32_16x16x32_bf16(vf, Af[s], C, 0, 0, 0); }
#if P4B_FP8
            y8[cc] = pg8::pk4_fp8(bf_lo(uu[cc].x) * (C[0] + bs) * pg8::YS_MUL, bf_hi(uu[cc].x) * (C[1] + bs) * pg8::YS_MUL, bf_lo(uu[cc].y) * (C[2] + bs) * pg8::YS_MUL, bf_hi(uu[cc].y) * (C[3] + bs) * pg8::YS_MUL);
            if ((cc & 3) == 3) { unsigned r0 = y8[cc - 3], r1_ = y8[cc - 2], r2 = y8[cc - 1], r3 = y8[cc];
                { auto p_ = __builtin_amdgcn_permlane16_swap(r0, r1_, false, false); r0 = p_[0]; r1_ = p_[1]; auto q_ = __builtin_amdgcn_permlane16_swap(r2, r3, false, false); r2 = q_[0]; r3 = q_[1]; }
                { auto p_ = __builtin_amdgcn_permlane32_swap(r0, r2, false, false); r0 = p_[0]; r2 = p_[1]; auto q_ = __builtin_amdgcn_permlane32_swap(r1_, r3, false, false); r1_ = q_[0]; r3 = q_[1]; }
                u32x4 ov; ov.x = r0; ov.y = r1_; ov.z = r2; ov.w = r3;
                *(u32x4*)((unsigned char*)ys + (t0 + itok) * BW + gg * 128 + 16 * (cc - 3 + gq)) = ov; } }
#else
            u32x2 o; o.x = cvt_pk_bf16(bf_lo(uu[cc].x) * (C[0] + bs), bf_hi(uu[cc].x) * (C[1] + bs)); o.y = cvt_pk_bf16(bf_lo(uu[cc].y) * (C[2] + bs), bf_hi(uu[cc].y) * (C[3] + bs));
            *(u32x2*)(yp + 16 * cc) = o; }
#endif
        __syncthreads();
    }
}

typedef float f32x16 __attribute__((ext_vector_type(16)));
__device__ __forceinline__ void p6_ln1_router(LAS unsigned char* lds, const Args& a, int grp, int tid, int wave, int lane) {
    unsigned char* ws = a.ws;
    const float* r1 = (const float*)(ws + WS_R1); bf16_t* hb = (bf16_t*)(ws + WS_HB); unsigned char* hq = ws + WS_H;
    LAS float* red = (LAS float*)lds;
    LAS float* logit = (LAS float*)(lds + 65536);
    LAS float* stat = (LAS float*)(lds + 73728);
    LAS float* cgb = (LAS float*)(lds + 74752);
    LAS float* pred = (LAS float*)(lds + 75264);
    LAS int* sel_e = (LAS int*)(lds + 79360);
    LAS float* sel_g = (LAS float*)(lds + 80384);
    LAS int* lrank = (LAS int*)(lds + 81408);
    LAS int* hist = (LAS int*)(lds + 82432);
    LAS int* base = (LAS int*)(lds + 82560);
    const float* Wr = a.in[I_WR]; const float* g1 = a.in[I_LN1G]; const float* b1 = a.in[I_LN1B];
    if (tid < 32) hist[tid] = 0;
    LAS float* ln1p = (LAS float*)(lds + 98304);
    for (int i = tid; i < DM; i += NTHR) { ln1p[i] = g1[i]; ln1p[DM + i] = b1[i]; }
    __syncthreads();
    if (tid < 64) cgb[tid] = ((const float*)(ws + WS_CGB))[tid];
    for (int ti = 0; ti < 8; ti += 2) {
        const int tl = wave * 8 + ti; const size_t t = (size_t)grp * 64 + tl;
        int lno6 = 0; asm volatile("" : "+v"(lno6));
        f32x4 xv[2][8]; float s[2] = {0.f, 0.f};
#pragma unroll
        for (int r = 0; r < 2; ++r)
#pragma unroll
            for (int i = 0; i < 8; ++i) { const u32x2 rw = *(const u32x2*)((const bf16_t*)r1 + (t + r) * DM + 4 * lane + 256 * i); xv[r][i] = (f32x4){bf_lo(rw.x), bf_hi(rw.x), bf_lo(rw.y), bf_hi(rw.y)};
                s[r] += (xv[r][i][0] + xv[r][i][1]) + (xv[r][i][2] + xv[r][i][3]); }
#pragma unroll
        for (int r = 0; r < 2; ++r) {
            const float mean = wave_sum(s[r]) * (1.0f / DM); float q = 0.f;
#pragma unroll
            for (int i = 0; i < 8; ++i) { xv[r][i] = xv[r][i] - mean; q += (xv[r][i][0] * xv[r][i][0] + xv[r][i][1] * xv[r][i][1]) + (xv[r][i][2] * xv[r][i][2] + xv[r][i][3] * xv[r][i][3]); }
            const float rstd = 1.0f / sqrtf(wave_sum(q) * (1.0f / DM) + LN_EPS);
#pragma unroll
            for (int i = 0; i < 8; ++i) { const int k = 4 * lane + 256 * i; const f32x4 gv = *(const LAS f32x4*)(ln1p + lno6 + k), bv = *(const LAS f32x4*)(ln1p + lno6 + DM + k);
                const f32x4 hv = xv[r][i] * rstd * gv + bv;
                *(unsigned*)(hq + (t + r) * DM + k) = pk4_fp8(hv[0], hv[1], hv[2], hv[3]); }
            if (lane == 0) { stat[(tl + r) * 2] = mean; stat[(tl + r) * 2 + 1] = rstd; f32x2 st; st[0] = mean; st[1] = rstd; *(f32x2*)((float*)hb + (t + r) * 2) = st; }
        }
    }
    {
        f32x16 C0, C1;
#pragma unroll
        for (int i = 0; i < 16; ++i) { C0[i] = 0.f; C1[i] = 0.f; }
        const int i = lane & 31, kh = lane >> 5;
        const bf16_t* ra0 = (const bf16_t*)r1 + ((size_t)grp * 64 + i) * DM + wave * 256 + 8 * kh; const bf16_t* ra1 = ra0 + (size_t)32 * DM;
        const bf16_t* wg = (const bf16_t*)(ws + WS_WG3) + (size_t)i * DM + wave * 256 + 8 * kh;
#pragma unroll 4
        for (int st = 0; st < 16; ++st) { const bf16x8 a0 = *(const bf16x8*)(ra0 + 16 * st), a1 = *(const bf16x8*)(ra1 + 16 * st);
#pragma unroll
            for (int pt = 0; pt < 2; ++pt) { const bf16x8 bw = *(const bf16x8*)(wg + (size_t)pt * NE * DM + 16 * st);
                C0 = __builtin_amdgcn_mfma_f32_32x32x16_bf16(a0, bw, C0, 0, 0, 0); C1 = __builtin_amdgcn_mfma_f32_32x32x16_bf16(a1, bw, C1, 0, 0, 0); } }
#pragma unroll
        for (int rg = 0; rg < 16; ++rg) { const int row = (rg & 3) + 8 * (rg >> 2) + 4 * kh; red[(wave * 64 + row) * 32 + i] = C0[rg]; red[(wave * 64 + 32 + row) * 32 + i] = C1[rg]; }
    }
    __syncthreads();
#pragma unroll
    for (int r = 0; r < 4; ++r) { const int idx = tid + 512 * r, tok = idx >> 5, e = idx & 31; float s = 0.f;
#pragma unroll
        for (int w = 0; w < 8; ++w) s += red[(w * 64 + tok) * 32 + e];
        logit[tok * 32 + (e ^ (tok & 31))] = stat[tok * 2 + 1] * (s - stat[tok * 2] * cgb[e]) + cgb[32 + e]; }
    __syncthreads();
    if (tid < 64) {
        float v[32];
#pragma unroll
        for (int e = 0; e < 32; ++e) v[e] = logit[tid * 32 + (e ^ (tid & 31))];
        unsigned taken = 0u; int se[4]; float sv[4];
#pragma unroll
        for (int rr = 0; rr < 4; ++rr) { float m = -INFINITY; int idx = 0;
#pragma unroll
            for (int e = 0; e < 32; ++e) { const bool ok = ((taken >> e) & 1u) == 0u && v[e] > m; m = ok ? v[e] : m; idx = ok ? e : idx; }
            se[rr] = idx; sv[rr] = m; taken |= 1u << idx; }
        const float e1 = __expf(sv[1] - sv[0]), e2 = __expf(sv[2] - sv[0]), e3 = __expf(sv[3] - sv[0]); const float inv = 1.0f / (1.0f + e1 + e2 + e3);
        const float gt[4] = {inv, e1 * inv, e2 * inv, e3 * inv};
#pragma unroll
        for (int rr = 0; rr < 4; ++rr) { const int slot = tid * 4 + rr; sel_e[slot] = se[rr]; sel_g[slot] = gt[rr]; lrank[slot] = atomicAdd((int*)(hist + se[rr]), 1); }
    }
    __syncthreads();
    unsigned* cntw = (unsigned*)(ws + WS_CTL) + CW_CNT;
    if (tid < 32) base[tid] = (int)__hip_atomic_fetch_add(cntw + 64 * tid, (unsigned)hist[tid], RLX_AGENT);
    __syncthreads();
    if (tid < 256) { const int ee = sel_e[tid], rank = base[ee] + lrank[tid]; const int t = grp * 64 + (tid >> 2);
        ((int*)(ws + WS_TOKE))[t * 4 + (tid & 3)] = ee; ((int*)(ws + WS_TOKR))[t * 4 + (tid & 3)] = rank;
        ((int*)(ws + WS_SLOTTOK))[(size_t)ee * T + rank] = t; ((float*)(ws + WS_SLOTGATE))[(size_t)ee * T + rank] = sel_g[tid]; }
    __syncthreads();
}

__device__ __forceinline__ void load_expert_tables(LAS unsigned char* lds, unsigned char* ws, int tid) {
    LAS int* cnt = (LAS int*)(lds + SMALL_OFF); LAS int* tpre = (LAS int*)(lds + SMALL_OFF + 256);
    unsigned* cntw = (unsigned*)(ws + WS_CTL) + CW_CNT;
    if (tid < 32) cnt[tid] = (int)__hip_atomic_load(cntw + 64 * tid, RLX_AGENT);
    __syncthreads();
    if (tid < 64) {
        const int tiles = tid < NE ? (cnt[tid] + 255) >> 8 : 0; int inc = tiles;
#pragma unroll
        for (int o = 1; o < 32; o <<= 1) { const int v = __shfl_up(inc, o); if ((tid & 63) >= o) inc += v; }
        if (tid < NE) tpre[tid] = inc - tiles;
        if (tid == NE - 1) tpre[NE] = inc; }
    __syncthreads();
}

constexpr int NPH = 10;
__global__ void __launch_bounds__(NTHR, 2) fwd_kernel(Args args) {
    extern __shared__ __attribute__((aligned(16))) unsigned char lds_raw[];
    LAS unsigned char* lds = (LAS unsigned char*)lds_raw;
    const int tid = threadIdx.x, lane = tid & 63, wave = __builtin_amdgcn_readfirstlane(tid >> 6);
    const int G = gridDim.x, bx = blockIdx.x; const int vcu = (G % 8 == 0) ? (bx % 8) * (G / 8) + bx / 8 : bx;
    unsigned char* ws = args.ws;
    volatile LAS unsigned* MISC = (volatile LAS unsigned*)(lds + MISC_OFF);
    if (tid < 64) MISC[tid] = 0u;
    __syncthreads();
    XcdBarrier bar; bar.bar = (unsigned*)(ws + WS_CTL) + CW_BAR; bar.x = 0; bar.st = nullptr;
    if (MK_N_LAUNCHES == 1) bar = xcd_barrier_post((unsigned*)(ws + WS_CTL) + CW_BAR, MISC + 8);
    const int lo = args.ph_lo, hi = args.ph_hi;
#ifndef PHASE_MASK
#define PHASE_MASK 0x3ff
#endif
#define IN(k) (((PHASE_MASK >> (k)) & 1) && lo <= (k) && (k) < hi)
#define BOTH(k) (IN(k) && IN((k) + 1))
#define GRID_BAR(k) do { if (BOTH(k)) xcd_barrier(bar); } while (0)
    bf16_t* Pbuf = (bf16_t*)(ws + WS_P);

    if (IN(0)) { p0_prologue(args, lds, vcu, G, wave, lane); __syncthreads(); if (PROBE_DBL == 0) { p0_prologue(args, lds, vcu, G, wave, lane); __syncthreads(); } GRID_BAR(0); }

    if (IN(1)) REPS(1) {
#if P1_I8
        const int sg = (bx >> 3) & 15;
        pg8::DenseI8 S; S.init((const bf16_t*)(ws + WS_XB), (const bf16_t*)(ws + WS_WIN), T, INC, DM / 2, G, bx); S.rep = DBL(1); S.ranged = 1;
        pg8::EpiProjT<true> E{Pbuf, (bf16_t*)(ws + WS_QKV), 1.0f, (const float*)(ws + WS_XS), (const float*)(ws + WS_WCS)};
        typedef pg8::DenseI8 P1Prob; typedef pg8::EpiProjT<true> P1Epi;
#elif P1_FP8
        {
            pg8::Dense Sz; Sz.init((const bf16_t*)(ws + WS_H + 64 * MiB), (const bf16_t*)(ws + WS_WIN + 32 * MiB), T, BW, DM, G, bx); Sz.pn_off = 36; Sz.rep = DBL(1);
            pg8::EpiProj Ez{Pbuf, (bf16_t*)(ws + WS_QKV), 1.0f, nullptr, nullptr};
            pg8::gemm_phase<pg8::EpiProj, pg8::Dense>(lds, Sz, Ez);
        }
        const int sg = (bx >> 3) % 15;
        pg8::Dense8 S; S.init((const bf16_t*)(ws + WS_XB), (const bf16_t*)(ws + WS_WIN), T, INC - BW, DM / 2, G, bx); S.gap_lo = 36; S.gap_n = 4; S.rep = DBL(1);
        pg8::EpiProj E{Pbuf, (bf16_t*)(ws + WS_QKV), pg8::W8_INV, nullptr, nullptr};
        typedef pg8::Dense8 P1Prob; typedef pg8::EpiProj P1Epi;
#else
        const int sg = (bx >> 3) & 15;
        pg8::Dense S; S.init((const bf16_t*)(ws + WS_XB), (const bf16_t*)(ws + WS_WIN), T, INC, DM, G, bx);
        pg8::EpiProj E{Pbuf, (bf16_t*)(ws + WS_QKV), 1.0f, nullptr, nullptr};
        typedef pg8::Dense P1Prob; typedef pg8::EpiProj P1Epi;
#endif
        S.i0 = 0; S.i1 = sg;
        pg8::gemm_phase<P1Epi, P1Prob>(lds, S, E);
        cvt8s_run<DM, 2 * EH, 2 * EH, 1>(args.in[I_WGU], ws + WS_WGU, NE * (DM / 128) * (2 * EH / 256), bx, G, tid, wave, lds, DBL(11));
        {
            const int gw = bx * NWAVES + wave, NGW = G * NWAVES; LAS unsigned char* scr = lds + wave * 8192;
            cvt8_run<BW, DM, DM, 0>(args.in[I_WBR], ws + WS_WBR, (BW / 128) * (DM / 32), gw, NGW, lane, scr);
#if P4B_FP8
            cvt8_run<BW, DM, DM, 0>(args.in[I_WBR] + (size_t)BW * DM, ws + WS_WBR + 4 * MiB, (BW / 128) * (DM / 32), gw, NGW, lane, scr);
#else
            { CvtJob j{args.in[I_WBR] + (size_t)BW * DM, (bf16_t*)(ws + WS_WBR) + (size_t)DM * BW, BW, DM, 0, 0}; cvt_run(j, (BW / 64) * (DM / 64), gw, NGW, lane, scr); }
#endif
#if P5_FP8
            cvt8_run<DM, DM, DM, 0>(args.in[I_WOUT], ws + WS_WOUT, (DM / 128) * (DM / 32), gw, NGW, lane, scr);
#else
            { CvtJob j{args.in[I_WOUT], (bf16_t*)(ws + WS_WOUT), DM, DM, 0, 0}; cvt_run(j, (DM / 64) * (DM / 64), gw, NGW, lane, scr); }
#endif
        }
        __syncthreads();
        S.i0 = sg; S.i1 = 1 << 28;
        pg8::gemm_phase<P1Epi, P1Prob>(lds, S, E);
        GRID_BAR(1);
    }

    if (IN(2)) REPS(2) {
        for (int u = vcu; u < 256 * DBL(12); u += G) sgu_unit(lds, args, Pbuf, (bf16_t*)(ws + WS_YS), u & 255, tid, wave, lane);
        attn_phase(lds, (const bf16_t*)(ws + WS_QKV), (bf16_t*)(ws + WS_OG), (float*)(ws + WS_LSE), args.in[I_RELB], vcu, G, DBL(2) * 3072, tid, wave, lane);
#if PROBE_PHASE == 12
        for (int u = vcu; u < 256; u += G) sgu_unit(lds, args, Pbuf, (bf16_t*)(ws + WS_YS), u, tid, wave, lane);
        for (int u = vcu; u < 256; u += G) sgu_unit(lds, args, Pbuf, (bf16_t*)(ws + WS_YS), u, tid, wave, lane);
        for (int u = vcu; u < 256; u += G) sgu_unit(lds, args, Pbuf, (bf16_t*)(ws + WS_YS), u, tid, wave, lane);
#endif
        GRID_BAR(2);
    }

    if (IN(3)) REPS(3) {
        const bf16_t* og = (const bf16_t*)(ws + WS_OG); const float* lse = (const float*)(ws + WS_LSE); bf16_t* ya = (bf16_t*)(ws + WS_YA);
        for (size_t i_ = (size_t)vcu * NTHR + tid; i_ < (size_t)T * 64 * DBL(3); i_ += (size_t)G * NTHR) { const size_t i = i_ % ((size_t)T * 64);
            const size_t t = i >> 6; const int h = (int)(i & 63) >> 3;
            const float l0 = lse[t * 8 + h], l1 = lse[((size_t)T + t) * 8 + h], l2 = lse[((size_t)2 * T + t) * 8 + h];
            const float m = fmaxf(l0, fmaxf(l1, l2)); const float e0 = __expf(l0 - m), e1 = __expf(l1 - m), e2 = __expf(l2 - m); const float inv = 1.0f / (e0 + e1 + e2);
            const float w0 = e0 * inv, w1 = e1 * inv, w2 = e2 * inv;
            const unsigned char* og8 = (const unsigned char*)og;
            const u32x4 a0 = *(const u32x4*)(og8 + i * 16), a1 = *(const u32x4*)(og8 + ((size_t)T * 64 + i) * 16), a2 = *(const u32x4*)(og8 + ((size_t)2 * T * 64 + i) * 16);
            u32x4 o;
#pragma unroll
            for (int c = 0; c < 4; ++c) {
                const f32x2 rlo = __builtin_amdgcn_cvt_pk_f32_fp8((int)a0[c], false) * w0 + __builtin_amdgcn_cvt_pk_f32_fp8((int)a1[c], false) * w1 + __builtin_amdgcn_cvt_pk_f32_fp8((int)a2[c], false) * w2;
                const f32x2 rhi = __builtin_amdgcn_cvt_pk_f32_fp8((int)a0[c], true) * w0 + __builtin_amdgcn_cvt_pk_f32_fp8((int)a1[c], true) * w1 + __builtin_amdgcn_cvt_pk_f32_fp8((int)a2[c], true) * w2;
                o[c] = pk4_fp8(rlo[0], rlo[1], rhi[0], rhi[1]); }
            *(u32x4*)((unsigned char*)ya + i * 16) = o;
        }
        GRID_BAR(3);
    }

    if (IN(4)) REPS(4) {
        { pg8::Dense8 S; S.init((const bf16_t*)(ws + WS_YA), (const bf16_t*)(ws + WS_WBR), T, DM, BW / 2, G, bx); S.rep = DBL(4);
          pg8::EpiBranch<0> E{Pbuf, (bf16_t*)(ws + WS_T0), (bf16_t*)(ws + WS_MP), pg8::W8_INV / pg8::YA_MUL};
          pg8::gemm_phase<pg8::EpiBranch<0>, pg8::Dense8>(lds, S, E); }
#if P4B_FP8
        { pg8::Dense8 S; S.init((const bf16_t*)(ws + WS_YS), (const bf16_t*)(ws + WS_WBR + 4 * MiB), T, DM, BW / 2, G, bx); S.rep = DBL(4);
          pg8::EpiBranch<1> E{Pbuf, (bf16_t*)(ws + WS_T0), (bf16_t*)(ws + WS_MP), pg8::W8_INV / pg8::YS_MUL};
          pg8::gemm_phase<pg8::EpiBranch<1>, pg8::Dense8>(lds, S, E); }
#else
        { pg8::Dense S; S.init((const bf16_t*)(ws + WS_YS), (const bf16_t*)(ws + WS_WBR) + (size_t)DM * BW, T, DM, BW, G, bx); S.rep = DBL(4);
          pg8::EpiBranch<1> E{Pbuf, (bf16_t*)(ws + WS_T0), (bf16_t*)(ws + WS_MP), 1.0f};
          pg8::gemm_phase<pg8::EpiBranch<1>, pg8::Dense>(lds, S, E); }
#endif
        GRID_BAR(4);
    }

    if (IN(5)) REPS(5) {
#if P5_FP8
        pg8::Dense8 S; S.init((const bf16_t*)(ws + WS_MP), (const bf16_t*)(ws + WS_WOUT), T, DM, DM / 2, G, bx); S.rep = DBL(5);
        pg8::EpiOut E{args.in[I_X], (float*)(ws + WS_R1), pg8::W8_INV / pg8::MP_MUL};
        pg8::gemm_phase<pg8::EpiOut, pg8::Dense8>(lds, S, E);
#else
        pg8::Dense S; S.init((const bf16_t*)(ws + WS_MP), (const bf16_t*)(ws + WS_WOUT), T, DM, DM, G, bx); S.rep = DBL(5);
        pg8::EpiOut E{args.in[I_X], (float*)(ws + WS_R1), 1.0f};
        pg8::gemm_phase<pg8::EpiOut, pg8::Dense>(lds, S, E);
#endif
#if PROBE_PHASE == 5
        pg8::gemm_phase<pg8::EpiOut, pg8::Dense>(lds, S, E);
#endif

        GRID_BAR(5);
    }

    if (IN(6)) {
        for (int grp = bx; grp < T / 64; grp += G) p6_ln1_router(lds, args, grp, tid, wave, lane);
        GRID_BAR(6);
    }

    if (IN(7)) REPS(7) {
        load_expert_tables(lds, ws, tid);
        LAS int* cnt = (LAS int*)(lds + SMALL_OFF); LAS int* tpre = (LAS int*)(lds + SMALL_OFF + 256); LAS int* toktab = (LAS int*)(lds + TOKTAB_OFF);
        pg8::Moe<true, true> S; S.A = (const bf16_t*)(ws + WS_H); S.Bt = (const bf16_t*)(ws + WS_WGU); S.K = DM / 2; S.nN = 16; S.G = G; S.c = bx; S.tpre = tpre; S.toktab = toktab; S.cnt = cnt; S.utab = (LAS int*)(lds + SMALL_OFF + 512); S.i0 = 0; S.i1 = 1 << 28; S.rep = 1;
        S.fill_units(tid);
        {
            const int* slot_tok = (const int*)(ws + WS_SLOTTOK);
            int tv[TOKTAB_UNITS / 2]; const int hsel = tid >> 8, row = tid & 255;
#pragma unroll
            for (int j = 0; j < TOKTAB_UNITS / 2; ++j) { pg8::Unit u; const bool ok = S.next(2 * j + hsel, u); const int rank = ok ? u.pm * 256 + row : 0;
                tv[j] = (ok && rank < cnt[u.e]) ? slot_tok[(size_t)u.e * T + rank] : 0; }
#pragma unroll
            for (int j = 0; j < TOKTAB_UNITS / 2; ++j) toktab[(2 * j + hsel) * 256 + row] = tv[j];
            __syncthreads();
        }
        pg8::EpiGU E{args.in[I_BGU], ws + WS_ACT, tpre};
        const int sg = (bx >> 3) & 15;
        S.i0 = 0; S.i1 = sg;
        pg8::gemm_phase<pg8::EpiGU, pg8::Moe<true, true>>(lds, S, E);
        cvt8s_run<EH, DM, DM, 0>(args.in[I_WDN], ws + WS_WDN, NE * (EH / 128) * (DM / 256), bx, G, tid, wave, lds, DBL(17));
        __syncthreads();
        S.i0 = sg; S.i1 = 1 << 28;
        pg8::gemm_phase<pg8::EpiGU, pg8::Moe<true, true>>(lds, S, E);
        GRID_BAR(7);
    }

    if (IN(8)) REPS(8) {
        load_expert_tables(lds, ws, tid);
        LAS int* cnt = (LAS int*)(lds + SMALL_OFF); LAS int* tpre = (LAS int*)(lds + SMALL_OFF + 256);
        pg8::Moe<false, true> S; S.A = (const bf16_t*)(ws + WS_ACT); S.Bt = (const bf16_t*)(ws + WS_WDN); S.K = EH / 2; S.nN = 8; S.G = G; S.c = bx; S.tpre = tpre; S.toktab = nullptr; S.cnt = cnt; S.utab = (LAS int*)(lds + SMALL_OFF + 512); S.i0 = 0; S.i1 = 1 << 28; S.rep = DBL(8);
        S.fill_units(tid);
        pg8::EpiDown E{args.in[I_BDN], ws + WS_Y, (const float*)(ws + WS_SLOTGATE), tpre, cnt};
        pg8::gemm_phase<pg8::EpiDown, pg8::Moe<false, true>>(lds, S, E);
#if PROBE_PHASE == 8
        pg8::gemm_phase<pg8::EpiDown, pg8::Moe<false, true>>(lds, S, E);
#endif

        GRID_BAR(8);
    }

    if (IN(9)) REPS(9) {
        load_expert_tables(lds, ws, tid);
        LAS int* tpre = (LAS int*)(lds + SMALL_OFF + 256);
        const float* hstat = (const float*)(ws + WS_HB); const bf16_t* r1b = (const bf16_t*)(ws + WS_R1); const float* g1 = args.in[I_LN1G]; const float* b1 = args.in[I_LN1B]; const unsigned char* y = ws + WS_Y;
        const int* toke = (const int*)(ws + WS_TOKE); const int* tokr = (const int*)(ws + WS_TOKR);
        const float* g2 = args.in[I_LN2G]; const float* b2 = args.in[I_LN2B];
        const size_t tbase = (size_t)vcu * NWAVES + wave, tstride = (size_t)G * NWAVES;
        LAS float* lnp = (LAS float*)lds;
        for (int i = tid; i < DM; i += NTHR) { lnp[i] = g1[i]; lnp[DM + i] = b1[i]; lnp[2 * DM + i] = g2[i]; lnp[3 * DM + i] = b2[i]; }
        __syncthreads();
        int srow_l = 0;
        { const size_t tt = (tbase + (size_t)(lane >> 2) * tstride) % (size_t)T; if (true) { const int e = toke[tt * 4 + (lane & 3)], rk = tokr[tt * 4 + (lane & 3)]; srow_l = tpre[e] * 256 + rk; } }
        int ti = 0;
        for (size_t t_ = tbase; t_ < (size_t)T * DBL(9); t_ += tstride, ++ti) { const size_t t = t_ % (size_t)T;
            size_t srow[4];
#pragma unroll
            for (int k = 0; k < 4; ++k) srow[k] = (size_t)__builtin_amdgcn_readlane(srow_l, (ti & 15) * 4 + k);
            const float mean1 = hstat[t * 2], rstd1 = hstat[t * 2 + 1];
            int lno = 0; asm volatile("" : "+v"(lno));
            const int lq = lane >> 4, lr = lane & 15, lcol = 16 * lr + 4 * lq, odd = lq & 1;
            f32x4 xv[8]; float s = 0.f;
#pragma unroll
            for (int i = 0; i < 8; i += 2) {
                u32x4 hw = *(const u32x4*)(r1b + t * DM + 256 * (i + odd) + 16 * lr + 4 * (lq - odd));
                { auto a_ = __builtin_amdgcn_permlane16_swap(hw.x, hw.z, false, false); hw.x = a_[0]; hw.z = a_[1]; auto b_ = __builtin_amdgcn_permlane16_swap(hw.y, hw.w, false, false); hw.y = b_[0]; hw.w = b_[1]; }
#pragma unroll
                for (int h2 = 0; h2 < 2; ++h2) { const int k0 = lcol + 256 * (i + h2); const unsigned wx = h2 ? hw.z : hw.x, wy = h2 ? hw.w : hw.y;
                    const f32x4 gl = *(const LAS f32x4*)(lnp + lno + k0), bl = *(const LAS f32x4*)(lnp + lno + DM + k0);
                    xv[i + h2] = (((f32x4){bf_lo(wx), bf_hi(wx), bf_lo(wy), bf_hi(wy)} - mean1) * rstd1 * gl + bl) * ALPHA; } }
#pragma unroll
            for (int c4 = 0; c4 < 2; ++c4) { f32x2 ylo[4], yhi[4];
#pragma unroll
                for (int i = 0; i < 4; ++i) { ylo[i] = (f32x2){0.f, 0.f}; yhi[i] = (f32x2){0.f, 0.f}; }
#pragma unroll
                for (int k = 0; k < 4; ++k) { const u32x4 w = *(const u32x4*)(y + srow[k] * DM + 256 * (4 * c4 + lq) + 16 * lr);
                    unsigned q0 = w.x, q1 = w.y, q2 = w.z, q3 = w.w;
                    { auto a_ = __builtin_amdgcn_permlane16_swap(q0, q1, false, false); q0 = a_[0]; q1 = a_[1]; auto b_ = __builtin_amdgcn_permlane16_swap(q2, q3, false, false); q2 = b_[0]; q3 = b_[1]; }
                    { auto a_ = __builtin_amdgcn_permlane32_swap(q0, q2, false, false); q0 = a_[0]; q2 = a_[1]; auto b_ = __builtin_amdgcn_permlane32_swap(q1, q3, false, false); q1 = b_[0]; q3 = b_[1]; }
                    ylo[0] += __builtin_amdgcn_cvt_pk_f32_fp8((int)q0, false); yhi[0] += __builtin_amdgcn_cvt_pk_f32_fp8((int)q0, true);
                    ylo[1] += __builtin_amdgcn_cvt_pk_f32_fp8((int)q1, false); yhi[1] += __builtin_amdgcn_cvt_pk_f32_fp8((int)q1, true);
                    ylo[2] += __builtin_amdgcn_cvt_pk_f32_fp8((int)q2, false); yhi[2] += __builtin_amdgcn_cvt_pk_f32_fp8((int)q2, true);
                    ylo[3] += __builtin_amdgcn_cvt_pk_f32_fp8((int)q3, false); yhi[3] += __builtin_amdgcn_cvt_pk_f32_fp8((int)q3, true); }
#pragma unroll
                for (int i = 0; i < 4; ++i) { f32x4& v = xv[4 * c4 + i];
                    v[0] += ylo[i][0] * (1.0f / pg8::Y_MUL); v[1] += ylo[i][1] * (1.0f / pg8::Y_MUL); v[2] += yhi[i][0] * (1.0f / pg8::Y_MUL); v[3] += yhi[i][1] * (1.0f / pg8::Y_MUL); } }
#pragma unroll
            for (int i = 0; i < 8; ++i) s += (xv[i][0] + xv[i][1]) + (xv[i][2] + xv[i][3]);
            const float mean = wave_sum(s) * (1.0f / DM); float q = 0.f;
#pragma unroll
            for (int i = 0; i < 8; ++i) { xv[i] = xv[i] - mean; q += (xv[i][0] * xv[i][0] + xv[i][1] * xv[i][1]) + (xv[i][2] * xv[i][2] + xv[i][3] * xv[i][3]); }
            const float rstd = 1.0f / sqrtf(wave_sum(q) * (1.0f / DM) + LN_EPS);
#pragma unroll
            for (int i = 0; i < 8; ++i) { const int k0 = lcol + 256 * i; const f32x4 gv = *(const LAS f32x4*)(lnp + lno + 2 * DM + k0), bv = *(const LAS f32x4*)(lnp + lno + 3 * DM + k0);
                *(f32x4*)(args.out + t * DM + k0) = xv[i] * rstd * gv + bv; }
        }
    }
#undef IN
#undef BOTH
#undef GRID_BAR
}

extern "C" void kernel_launch(void* const* d_in, const int* in_sizes, int n_in, void* d_out, int out_size, void* d_ws, size_t ws_size, hipStream_t stream) {
    static int grid = 0;
    if (grid == 0) {
        if (n_in != 19 || out_size != T * DM || ws_size < WS_END) { fprintf(stderr, "kernel_launch: unexpected shapes (n_in %d out %d ws %zu)\n", n_in, out_size, ws_size); grid = -1; return; }
        int dev = 0, cus = 0, per_cu = 0;
        if (hipGetDevice(&dev) != hipSuccess || hipDeviceGetAttribute(&cus, hipDeviceAttributeMultiprocessorCount, dev) != hipSuccess) { grid = -1; return; }
        if (hipFuncSetAttribute((const void*)fwd_kernel, hipFuncAttributeMaxDynamicSharedMemorySize, LDS_BYTES) != hipSuccess) { fprintf(stderr, "kernel_launch: hipFuncSetAttribute failed\n"); grid = -1; return; }
        if (hipOccupancyMaxActiveBlocksPerMultiprocessor(&per_cu, (const void*)fwd_kernel, NTHR, LDS_BYTES) != hipSuccess || per_cu < 1) { fprintf(stderr, "kernel_launch: occupancy query says %d\n", per_cu); }
        (void)hipGetLastError();
        grid = cus;
    }
    if (grid < 0) return;
    (void)hipMemsetAsync((char*)d_ws + WS_CTL, 0, CTL_ZERO_BYTES, stream);
    Args a{};
    for (int i = 0; i < 19; ++i) a.in[i] = (const float*)d_in[i];
    a.out = (float*)d_out; a.ws = (unsigned char*)d_ws;
#if MK_N_LAUNCHES == 1
    a.ph_lo = 0; a.ph_hi = NPH;
    hipLaunchKernelGGL(fwd_kernel, dim3(grid), dim3(NTHR), LDS_BYTES, stream, a);
#else
    for (int p = 0; p < NPH; ++p) { a.ph_lo = p; a.ph_hi = p + 1; hipLaunchKernelGGL(fwd_kernel, dim3(grid), dim3(NTHR), LDS_BYTES, stream, a); }
#endif
}
```
